# Optimizing an MI355X kernel written in HIP

```python
import jax, jax.numpy as jnp
from jax import lax
import numpy as np

D_MODEL = 1024
BATCH = 8
SEQ = 2048
DEPTH = 1

CHUNK = 64
D_MIX = D_MODEL
D_GMLP = D_MIX // 2
GMLP_GROUPS = 4
GMLP_GROUP_DIM = D_GMLP // GMLP_GROUPS
GMLP_BLOCK = 128
D_SB = D_MIX - D_GMLP
SB_HEADS = 8
SB_HEAD_DIM = D_SB // SB_HEADS
SB_QBLOCK = 128
N_EXPERTS = 64
TOP_K = 8
N_GROUPS = 8
TOPK_GROUPS = 4
D_EXPERT = D_MODEL // 4
D_SHARED = D_EXPERT
ROUTED_SCALE = 2.5
EPS = 1e-6
D_IN = 2 * D_GMLP + 3 * D_SB

kernel_name = 'hybrid_gmlp_stickbreak_moe_block'


def rmsnorm(x, g):
    xf = x.astype(jnp.float32)
    y = xf * lax.rsqrt(jnp.mean(xf * xf, axis=-1, keepdims=True) + EPS)
    return (y * g.astype(jnp.float32)).astype(x.dtype)


def layernorm(x, g, b):
    xf = x.astype(jnp.float32)
    mu = jnp.mean(xf, axis=-1, keepdims=True)
    var = jnp.mean(jnp.square(xf - mu), axis=-1, keepdims=True)
    y = (xf - mu) * lax.rsqrt(var + EPS)
    return (y * g.astype(jnp.float32) + b.astype(jnp.float32)).astype(x.dtype)


def gmlp_spatial_gating(u, v, ln_g, ln_b, w_s, b_s):
    B, S, _ = v.shape
    v = layernorm(v, ln_g, ln_b)
    i = jnp.arange(GMLP_BLOCK)
    mask = (i[None, :] // CHUNK) <= (i[:, None] // CHUNK)
    w = jnp.where(mask, w_s, 0.0)
    vb = v.reshape(B, S // GMLP_BLOCK, GMLP_BLOCK, GMLP_GROUPS, GMLP_GROUP_DIM)
    mixed = jnp.einsum('gij,bnjgc->bnigc', w, vb) + b_s.T[None, None, :, :, None]
    return u * mixed.reshape(B, S, D_GMLP)


def stick_breaking_attention(q, k, v):
    S = q.shape[2]
    scale = SB_HEAD_DIM ** -0.5
    outs = []
    for blk in range(S // SB_QBLOCK):
        q0 = blk * SB_QBLOCK
        kv_len = q0 + SB_QBLOCK
        qb = q[:, :, q0:kv_len].astype(jnp.float32)
        kb = k[:, :, :kv_len].astype(jnp.float32)
        vb = v[:, :, :kv_len]
        z = jnp.einsum('bhqd,bhkd->bhqk', qb, kb) * scale
        t = q0 + jnp.arange(SB_QBLOCK)[:, None]
        s = jnp.arange(kv_len)[None, :]
        mask = s < t
        log_1mb = jnp.where(mask, jax.nn.log_sigmoid(-z), 0.0)
        between = lax.cumsum(log_1mb, axis=3, reverse=True) - log_1mb
        a = jnp.where(mask, jnp.exp(jax.nn.log_sigmoid(z) + between), 0.0)
        outs.append(jnp.einsum('bhqk,bhkd->bhqd', a.astype(vb.dtype), vb))
    return jnp.concatenate(outs, axis=2)


def route(h, w_router, router_bias):
    T = h.shape[0]
    scores = jax.nn.sigmoid(h.astype(jnp.float32) @ w_router.astype(jnp.float32))
    biased = scores + router_bias.astype(jnp.float32)
    grouped = biased.reshape(T, N_GROUPS, N_EXPERTS // N_GROUPS)
    group_score = lax.top_k(grouped, 2)[0].sum(-1)
    _, top_groups = lax.top_k(group_score, TOPK_GROUPS)
    group_mask = (top_groups[:, :, None] == jnp.arange(N_GROUPS)[None, None, :]).any(axis=1)
    expert_mask = jnp.repeat(group_mask, N_EXPERTS // N_GROUPS, axis=1)
    masked = jnp.where(expert_mask, biased, -jnp.inf)
    _, idx = lax.top_k(masked, TOP_K)
    w = jnp.take_along_axis(scores, idx, axis=1)
    w = w / jnp.sum(w, axis=-1, keepdims=True) * ROUTED_SCALE
    return jnp.einsum('tk,tke->te', w, jax.nn.one_hot(idx, N_EXPERTS, dtype=jnp.float32))


def moe_ffn(h, w_router, router_bias, w_gate, w_up, w_down, ws_gate, ws_up, ws_down):
    B, S, D = h.shape
    gates = route(h.reshape(B * S, D), w_router, router_bias).reshape(B, S, N_EXPERTS).astype(h.dtype)

    def per_seq(args):
        hs, gs = args
        g = jnp.einsum('sd,edf->sef', hs, w_gate)
        u = jnp.einsum('sd,edf->sef', hs, w_up)
        act = jax.nn.silu(g) * u * gs[:, :, None]
        return jnp.einsum('sef,efd->sd', act, w_down)

    routed = lax.map(per_seq, (h, gates))
    shared = (jax.nn.silu(h @ ws_gate) * (h @ ws_up)) @ ws_down
    return routed + shared


def setup_inputs(seed: int = 0) -> dict:
    key = jax.random.key(seed)
    ks = jax.random.split(key, 24)
    n = lambda k, shape, s: jax.random.normal(k, shape, jnp.float32) * s
    L, D, E, F = DEPTH, D_MODEL, N_EXPERTS, D_EXPERT
    return {
        'x': n(ks[0], (BATCH, SEQ, D), 1.0),
        'c': n(ks[1], (BATCH, D), 1.0),
        'w_ada': n(ks[2], (L, D, 6 * D), 0.5 * D ** -0.5),
        'b_ada': n(ks[3], (L, 6 * D), 0.02),
        'g_pre_mix': 1.0 + n(ks[4], (L, D), 0.02),
        'w_in': n(ks[5], (L, D, D_IN), D ** -0.5),
        'ln_sgu_g': 1.0 + n(ks[6], (L, D_GMLP), 0.02),
        'ln_sgu_b': n(ks[7], (L, D_GMLP), 0.02),
        'w_spatial': n(ks[8], (L, GMLP_GROUPS, GMLP_BLOCK, GMLP_BLOCK), GMLP_BLOCK ** -0.5),
        'b_spatial': 1.0 + n(ks[9], (L, GMLP_GROUPS, GMLP_BLOCK), 0.1),
        'g_branch': 1.0 + n(ks[10], (L, D_MIX), 0.02),
        'w_out': n(ks[11], (L, D_MIX, D), D_MIX ** -0.5),
        'g_post_mix': 1.0 + n(ks[12], (L, D), 0.02),
        'g_pre_ffn': 1.0 + n(ks[13], (L, D), 0.02),
        'w_router': n(ks[14], (L, D, E), D ** -0.5),
        'router_bias': n(ks[15], (L, E), 0.01),
        'w_gate': n(ks[16], (L, E, D, F), D ** -0.5),
        'w_up': n(ks[17], (L, E, D, F), D ** -0.5),
        'w_down': n(ks[18], (L, E, F, D), F ** -0.5),
        'ws_gate': n(ks[19], (L, D, D_SHARED), D ** -0.5),
        'ws_up': n(ks[20], (L, D, D_SHARED), D ** -0.5),
        'ws_down': n(ks[21], (L, D_SHARED, D), D_SHARED ** -0.5),
        'g_post_ffn': 1.0 + n(ks[22], (L, D), 0.02),
    }


def reference(x, c, w_ada, b_ada, g_pre_mix, w_in, ln_sgu_g, ln_sgu_b, w_spatial, b_spatial,
              g_branch, w_out, g_post_mix, g_pre_ffn, w_router, router_bias, w_gate, w_up,
              w_down, ws_gate, ws_up, ws_down, g_post_ffn):
    B, S, D = x.shape
    sc = jax.nn.silu(c)
    for l in range(DEPTH):
        mod = (sc @ w_ada[l] + b_ada[l])[:, None, :]
        sh1, sc1, ga1, sh2, sc2, ga2 = jnp.split(mod, 6, axis=-1)

        h = rmsnorm(x, g_pre_mix[l]) * (1.0 + sc1) + sh1
        proj = h @ w_in[l]
        uv = jax.nn.gelu(proj[..., :2 * D_GMLP])
        u, v = uv[..., :D_GMLP], uv[..., D_GMLP:]
        q, k, vv = jnp.split(proj[..., 2 * D_GMLP:], 3, axis=-1)
        to_heads = lambda t: t.reshape(B, S, SB_HEADS, SB_HEAD_DIM).transpose(0, 2, 1, 3)
        o_sb = stick_breaking_attention(to_heads(q), to_heads(k), to_heads(vv))
        o_sb = o_sb.transpose(0, 2, 1, 3).reshape(B, S, D_SB)
        o_g = gmlp_spatial_gating(u, v, ln_sgu_g[l], ln_sgu_b[l], w_spatial[l], b_spatial[l])
        mixed = jnp.concatenate([rmsnorm(o_g, g_branch[l, :D_GMLP]),
                                 rmsnorm(o_sb, g_branch[l, D_GMLP:])], axis=-1)
        x = x + ga1 * rmsnorm(mixed @ w_out[l], g_post_mix[l])

        h = rmsnorm(x, g_pre_ffn[l]) * (1.0 + sc2) + sh2
        y = moe_ffn(h, w_router[l], router_bias[l], w_gate[l], w_up[l], w_down[l],
                    ws_gate[l], ws_up[l], ws_down[l])
        x = x + ga2 * rmsnorm(y, g_post_ffn[l])
    return x
```

```cpp
#include <hip/hip_runtime.h>
#include <cstdint>
#include <cstdio>

constexpr int NB = 8, SEQ = 2048, DM = 1024, NT = NB * SEQ;
constexpr int DG = 512, DSB = 512, NH = 8, HD = 64;
constexpr int NE = 64, TOPK = 8, NGRP = 8, TKG = 4, FE = 256;
constexpr float EPS = 1e-6f;
constexpr float ROUTED_SCALE = 2.5f;
constexpr float LOG2E = 1.4426950408889634f;

typedef unsigned short bf16;
__host__ __device__ __forceinline__ bf16 f2bf(float f) { unsigned u = __builtin_bit_cast(unsigned, f); return (bf16)((u + 0x7fffu + ((u >> 16) & 1u)) >> 16); }
__host__ __device__ __forceinline__ float bf2f(bf16 h) { unsigned u = ((unsigned)h) << 16; return __builtin_bit_cast(float, u); }

constexpr size_t MiB = 1u << 20;
constexpr size_t WS_CTL = 0;
constexpr size_t WS_MOD = 1 * MiB;
constexpr size_t WS_WDT = 2 * MiB;
constexpr size_t WS_TOPK = 35 * MiB;
constexpr size_t WS_LIST = 36 * MiB;
constexpr size_t WS_RB = 45 * MiB;
constexpr size_t WS_VT = WS_RB + 64 * MiB;
constexpr size_t WS_KF = 239 * MiB;
constexpr size_t WS_RA = 133 * MiB;
constexpr size_t WS_WGUT = 165 * MiB;
constexpr size_t WS_WINT = 230 * MiB;
constexpr size_t WS_WOUTT = 235 * MiB;
constexpr size_t WS_WSP = 237 * MiB;
constexpr size_t WS_WRT = 238 * MiB;
constexpr size_t WS_OSB = 239 * MiB;
constexpr size_t WS_YP = 165 * MiB;
constexpr size_t WS_END = 293 * MiB;
constexpr int LATE_DOWN = 64;
constexpr int CTL_GCOUNT = 1024;


struct P {
    const float *x, *c, *w_ada, *b_ada, *g_pre_mix, *w_in, *ln_g, *ln_b, *w_sp, *b_sp, *g_branch, *w_out, *g_post_mix, *g_pre_ffn,
        *w_router, *router_bias, *w_gate, *w_up, *w_down, *ws_gate, *ws_up, *ws_down, *g_post_ffn;
    float* out;
    unsigned char* ws;
};

__device__ __forceinline__ float block_sum(float v, float* red) {
    for (int o = 32; o > 0; o >>= 1) v += __shfl_xor(v, o);
    __syncthreads();
    if ((threadIdx.x & 63) == 0) red[threadIdx.x >> 6] = v;
    __syncthreads();
    return red[0] + red[1] + red[2] + red[3];
}
__device__ __forceinline__ float silu_f(float v) { return v / (1.f + __expf(-v)); }
__device__ __forceinline__ float gelu_tanh(float v) { const float u = 0.7978845608028654f * (v + 0.044715f * v * v * v); return 0.5f * v * (1.f + tanhf(u)); }

#define LAS __attribute__((address_space(3)))
#define GAS __attribute__((address_space(1)))
typedef short bf16x8 __attribute__((ext_vector_type(8)));
typedef float f32x4 __attribute__((ext_vector_type(4)));
typedef float f32x2 __attribute__((ext_vector_type(2)));
typedef unsigned u32x4 __attribute__((ext_vector_type(4)));
typedef unsigned u32x2 __attribute__((ext_vector_type(2)));
constexpr int NWAVES = 8, NTHR = 512;
constexpr int RING_BYTES = 131072, LDS_BYTES = 147456;
constexpr int LDS_MISC = RING_BYTES;

__device__ __forceinline__ unsigned cvt_pk_bf16(float lo, float hi) { unsigned r; asm volatile("v_cvt_pk_bf16_f32 %0, %1, %2" : "=v"(r) : "v"(lo), "v"(hi)); return r; }
template <int CTRL> __device__ __forceinline__ float dppf(float v) { return __builtin_bit_cast(float, __builtin_amdgcn_update_dpp(0, __builtin_bit_cast(int, v), CTRL, 0xf, 0xf, true)); }
__device__ __forceinline__ float rdlane(float v, int l) { return __builtin_bit_cast(float, __builtin_amdgcn_readlane(__builtin_bit_cast(int, v), l)); }
__device__ __forceinline__ float wave_sum(float v) {
    v += dppf<0xB1>(v); v += dppf<0x4E>(v); v += dppf<0x141>(v); v += dppf<0x140>(v);
    return (rdlane(v, 0) + rdlane(v, 16)) + (rdlane(v, 32) + rdlane(v, 48));
}
__device__ __forceinline__ float group8_max(float v) {
    v = __builtin_fmaxf(v, dppf<0xB1>(v)); v = __builtin_fmaxf(v, dppf<0x4E>(v)); v = __builtin_fmaxf(v, dppf<0x141>(v)); return v;
}
__device__ __forceinline__ float fast_sigmoid(float v) { return __builtin_amdgcn_rcpf(1.f + __builtin_amdgcn_exp2f(-LOG2E * v)); }
__device__ __forceinline__ float gelu_fast(float v) {
    const float u2 = v * (1.5957691216057308f + 0.07135481282748009f * v * v);
    return v * __builtin_amdgcn_rcpf(1.f + __builtin_amdgcn_exp2f(-LOG2E * u2));
}


typedef float f32x16 __attribute__((ext_vector_type(16)));
typedef short s16x4 __attribute__((ext_vector_type(4)));
typedef __bf16 bf16x2_t __attribute__((ext_vector_type(2)));
__device__ __forceinline__ unsigned cvtpk(float lo, float hi) { f32x2 v = {lo, hi}; bf16x2_t b = __builtin_convertvector(v, bf16x2_t); return __builtin_bit_cast(unsigned, b); }
__device__ __forceinline__ float bflo(unsigned u) { return __builtin_bit_cast(float, u << 16); }
__device__ __forceinline__ float bfhi(unsigned u) { return __builtin_bit_cast(float, u & 0xffff0000u); }
#define MFMA32(a, b, c) __builtin_amdgcn_mfma_f32_32x32x16_bf16((a), (b), (c), 0, 0, 0)

__device__ __forceinline__ void sb_tile(f32x16& p, float& carry, const bool diag, const int kvrel, const int hi) {
    float R[16], X[16];
#pragma unroll
    for (int r = 0; r < 16; ++r) { const float z = __builtin_amdgcn_fmed3f(p[r], -126.f, 126.f);
        const float e = __builtin_amdgcn_exp2f(z); float rr = __builtin_amdgcn_rcpf(1.f + e); float b = e * rr;
        if (diag) { const int kr = kvrel + (r & 3) + 8 * (r >> 2); if (kr >= 0) { rr = 1.f; b = 0.f; } }
        R[r] = rr; p[r] = b; }
    float T[4];
#pragma unroll
    for (int g = 0; g < 4; ++g) { X[4 * g + 3] = 1.f; X[4 * g + 2] = R[4 * g + 3]; X[4 * g + 1] = X[4 * g + 2] * R[4 * g + 2]; X[4 * g] = X[4 * g + 1] * R[4 * g + 1]; T[g] = X[4 * g] * R[4 * g]; }
    float Pp[4], S[4];
#pragma unroll
    for (int g = 0; g < 4; ++g) { const auto sw = __builtin_amdgcn_permlane32_swap(__float_as_uint(T[g]), __float_as_uint(T[g]), false, false);
        const float lo_ = __uint_as_float(sw[0]), hi_ = __uint_as_float(sw[1]); Pp[g] = hi == 0 ? hi_ : 1.f; S[g] = lo_ * hi_; }
    const float u3 = carry, u2 = u3 * S[3], u1 = u2 * S[2], u0 = u1 * S[1];
    const float off[4] = {u0 * Pp[0], u1 * Pp[1], u2 * Pp[2], u3 * Pp[3]};
    carry = u0 * S[0];
#pragma unroll
    for (int r = 0; r < 16; ++r) p[r] = p[r] * (X[r] * off[r >> 2]);
}

namespace pg8 {
constexpr int BM = 256, BK = 64, HALF = 128, HTB = HALF * BK * 2;
__host__ __device__ __forceinline__ int lds_byte(int r, int c) { const int st = (r >> 4) * 2 + (c >> 5), rr = r & 15, cc = c & 31, ob = rr * 64 + cc * 2; return st * 1024 + (ob ^ (((ob >> 9) & 1) << 5)); }
__host__ __device__ __forceinline__ void stage_rc(int b, int& R, int& C) { const int st = b / 1024, sb = b % 1024, swz = sb ^ (((sb >> 9) & 1) << 5); R = (st >> 1) * 16 + swz / 64; C = (st & 1) * 32 + (swz % 64) / 2; }
__host__ __device__ __forceinline__ int perm32(int rho) { const int n = rho >> 4, i = rho & 15; return 8 * (i >> 2) + 4 * n + (i & 3); }

struct Unit { const char* A; const char* B; const int* lst; int gather, pm, pn, nvalid, aux, tb; };

template <class Epi, class Sched>
__device__ __forceinline__ void gemm_phase(LAS unsigned char* lds, const int K, const Sched& S, const Epi& E) {
    const int tid = threadIdx.x, wid = __builtin_amdgcn_readfirstlane(tid >> 6), lane = tid & 63, wr = wid >> 2, wc = wid & 3, fr = lane & 15, fq = lane >> 4;
    const int nt = K / BK;
    unsigned voffB[2];
#pragma unroll
    for (int i = 0; i < 2; ++i) { int R_, C_; stage_rc(tid * 16 + i * 8192, R_, C_); const int Rb = Epi::PERM ? ((R_ & ~31) + perm32(R_ & 31)) : R_; voffB[i] = (unsigned)(Rb * K + C_) * 2u; }
    const size_t kstep = (size_t)(BK * 2);
    const size_t hstepB = (size_t)HALF * K * 2;
    const unsigned ldsw = (unsigned)wid * 1024u;
    const int aoff = lds_byte(wr * 64 + fr, fq * 8), boff = lds_byte(wc * 32 + fr, fq * 8);
#define PG8_SA(b, h) (((b) * 2 + (h)) * HTB)
#define PG8_SB(b, h) ((4 + (b) * 2 + (h)) * HTB)
#define PG8_STAGE2(bufoff, gbase, v0, v1) do { \
        __builtin_amdgcn_global_load_lds((const unsigned*)((const char*)(gbase) + (v0)), (LAS unsigned*)(lds + (bufoff) + ldsw), 16, 0, 0); \
        __builtin_amdgcn_global_load_lds((const unsigned*)((const char*)(gbase) + (v1)), (LAS unsigned*)(lds + (bufoff) + ldsw + 8192), 16, 0, 0); } while (0)
#define PG8_STAGEB(bufoff, gbase) PG8_STAGE2(bufoff, gbase, voffB[0], voffB[1])
#define PG8_LDA(dst, b, h) do { _Pragma("unroll") for (int m = 0; m < 4; ++m) _Pragma("unroll") for (int k = 0; k < 2; ++k) dst[m][k] = *(const LAS bf16x8*)(lds + PG8_SA(b, h) + aoff + m * 2048 + k * 1024); } while (0)
#define PG8_LDB(dst, b, h) do { _Pragma("unroll") for (int n = 0; n < 2; ++n) _Pragma("unroll") for (int k = 0; k < 2; ++k) dst[n][k] = *(const LAS bf16x8*)(lds + PG8_SB(b, h) + boff + n * 2048 + k * 1024); } while (0)
#define PG8_MMA(ai, bj, At, Bt) do { __builtin_amdgcn_s_setprio(1); _Pragma("unroll") for (int m = 0; m < 4; ++m) _Pragma("unroll") for (int n = 0; n < 2; ++n) _Pragma("unroll") for (int k = 0; k < 2; ++k) \
        acc[ai][bj][m][n] = __builtin_amdgcn_mfma_f32_16x16x32_bf16(Bt[n][k], At[m][k], acc[ai][bj][m][n], 0, 0, 0); __builtin_amdgcn_s_setprio(0); } while (0)
#define PG8_WAIT_V(n) asm volatile("s_waitcnt vmcnt(" #n ")" ::: "memory")
#define PG8_WAIT_L(n) asm volatile("s_waitcnt lgkmcnt(" #n ")" ::: "memory")
#define PG8_BAR __builtin_amdgcn_s_barrier()
#define PG8_SCHED __builtin_amdgcn_sched_barrier(0)
#define PG8_TBL(i) (LDS_MISC + 2048 + ((i) % 3) * 2048)
#define PG8_IDXDMA(u, tboff) do { if ((u).lst) { const int e_ = min(32 * wid + (lane >> 1), (u).nvalid - 1); \
        __builtin_amdgcn_global_load_lds((const unsigned*)((u).lst + e_ * 2 + (lane & 1)), (LAS unsigned*)(lds + (tboff) + 256 * wid), 4, 0, 0); } } while (0)
#define PG8_AOFFS(u, o00, o01, o10, o11) do { int Rr[2], Cc[2]; stage_rc((int)threadIdx.x * 16, Rr[0], Cc[0]); stage_rc((int)threadIdx.x * 16 + 8192, Rr[1], Cc[1]); \
        int r00 = Rr[0], r01 = Rr[1], r10 = Rr[0] + HALF, r11 = Rr[1] + HALF; \
        if ((u).gather) { const LAS int* tb_ = (const LAS int*)(lds + (u).tb); r00 = tb_[2 * r00] >> 3; r01 = tb_[2 * r01] >> 3; r10 = tb_[2 * r10] >> 3; r11 = tb_[2 * r11] >> 3; } \
        o00 = (unsigned)(r00 * K + Cc[0]) * 2u; o01 = (unsigned)(r01 * K + Cc[1]) * 2u; o10 = (unsigned)(r10 * K + Cc[0]) * 2u; o11 = (unsigned)(r11 * K + Cc[1]) * 2u; } while (0)
    Unit cur, nxt; int ui = 0;
    if (!S.next(0, cur)) return;
    f32x4 acc[2][2][4][2];
#pragma unroll
    for (int a = 0; a < 2; ++a)
#pragma unroll
        for (int b = 0; b < 2; ++b)
#pragma unroll
            for (int m = 0; m < 4; ++m)
#pragma unroll
                for (int n = 0; n < 2; ++n) acc[a][b][m][n] = (f32x4){0.f, 0.f, 0.f, 0.f};
    bf16x8 At[4][2], B0[2][2], B1[2][2];
    unsigned c00, c01, c10, c11;
    cur.tb = PG8_TBL(0);
    if (cur.lst) { PG8_IDXDMA(cur, cur.tb); PG8_WAIT_V(0); }
    __syncthreads();
    PG8_AOFFS(cur, c00, c01, c10, c11);
    const char* cA = cur.A; const char* cB = cur.B;
    PG8_STAGEB(PG8_SB(0, 0), cB); PG8_STAGEB(PG8_SB(0, 1), cB + hstepB); PG8_STAGE2(PG8_SA(0, 0), cA, c00, c01); PG8_STAGE2(PG8_SA(0, 1), cA, c10, c11);
    if (wr == 1) PG8_BAR;
    PG8_WAIT_V(2); PG8_BAR;
    PG8_STAGEB(PG8_SB(1, 0), cB + kstep); PG8_STAGE2(PG8_SA(1, 0), cA + kstep, c00, c01); PG8_STAGEB(PG8_SB(1, 1), cB + hstepB + kstep);
    PG8_WAIT_V(6); PG8_BAR;
    for (;;) {
        const bool has_next = S.next(ui + 1, nxt);
        const char* nA; const char* nB;
        if (has_next) { nA = nxt.A; nB = nxt.B; nxt.tb = PG8_TBL(ui + 1); PG8_IDXDMA(nxt, nxt.tb); } else { nA = cA; nB = cB; }
#pragma unroll 1
        for (int t = 0; t < nt; t += 2) {
            const bool last = (t == nt - 2);
            const char* a1 = cA + (size_t)(t + 1) * kstep;
            const char* a2 = last ? nA : cA + (size_t)(t + 2) * kstep; const char* b2 = last ? nB : cB + (size_t)(t + 2) * kstep;
            const char* a3 = a2 + kstep; const char* b3 = b2 + kstep;
            PG8_LDB(B0, 0, 0); PG8_LDB(B1, 0, 1); PG8_SCHED; PG8_LDA(At, 0, 0); PG8_STAGE2(PG8_SA(1, 1), a1, c10, c11);
            PG8_WAIT_V(8); PG8_WAIT_L(0); PG8_BAR; PG8_MMA(0, 0, At, B0); PG8_MMA(0, 1, At, B1); PG8_BAR; PG8_SCHED;
            if (last && has_next) { PG8_AOFFS(nxt, c00, c01, c10, c11); PG8_SCHED; }
            PG8_LDA(At, 0, 1); PG8_STAGEB(PG8_SB(0, 0), b2); PG8_STAGEB(PG8_SB(0, 1), b2 + hstepB); PG8_STAGE2(PG8_SA(0, 0), a2, c00, c01);
            PG8_WAIT_V(8); PG8_WAIT_L(0); PG8_BAR; PG8_MMA(1, 0, At, B0); PG8_MMA(1, 1, At, B1); PG8_BAR; PG8_SCHED;
            PG8_LDB(B0, 1, 0); PG8_LDB(B1, 1, 1); PG8_SCHED; PG8_LDA(At, 1, 0); PG8_STAGE2(PG8_SA(0, 1), a2, c10, c11);
            PG8_WAIT_V(8); PG8_WAIT_L(0); PG8_BAR; PG8_MMA(0, 0, At, B0); PG8_MMA(0, 1, At, B1); PG8_BAR; PG8_SCHED;
            PG8_LDA(At, 1, 1); PG8_STAGEB(PG8_SB(1, 0), b3); PG8_STAGEB(PG8_SB(1, 1), b3 + hstepB); PG8_STAGE2(PG8_SA(1, 0), a3, c00, c01);
            PG8_WAIT_V(8); PG8_WAIT_L(0); PG8_BAR; PG8_MMA(1, 0, At, B0); PG8_MMA(1, 1, At, B1); PG8_BAR; PG8_SCHED;
        }
        if (wr == 0) PG8_BAR;
        E(acc, cur, wr, wc, fr, fq, lds);
        if (!has_next) break;
#pragma unroll
        for (int a = 0; a < 2; ++a)
#pragma unroll
            for (int b = 0; b < 2; ++b)
#pragma unroll
                for (int m = 0; m < 4; ++m)
#pragma unroll
                    for (int n = 0; n < 2; ++n) acc[a][b][m][n] = (f32x4){0.f, 0.f, 0.f, 0.f};
        cur = nxt; cA = nA; cB = nB; ++ui;
        if (wr == 1) PG8_BAR;
    }
    PG8_WAIT_V(0);
    PG8_BAR;
#undef PG8_SA
#undef PG8_SB
#undef PG8_STAGE2
#undef PG8_STAGEB
#undef PG8_LDA
#undef PG8_LDB
#undef PG8_MMA
#undef PG8_WAIT_V
#undef PG8_WAIT_L
#undef PG8_BAR
#undef PG8_SCHED
#undef PG8_AOFFS
#undef PG8_IDXDMA
#undef PG8_TBL
}
}

struct DenseOrder {
    const char* A; const char* B; int K, nM, nN, nwg, G, c;
    __device__ void init(const void* A_, const void* B_, int M, int N, int K_, int G_, int c_) { A = (const char*)A_; B = (const char*)B_; K = K_; nM = M / 256; nN = N / 256; nwg = nM * nN; G = G_; c = c_; }
    __device__ bool next(int i, pg8::Unit& u) const {
        const long L = (long)i * G + c; if (L >= nwg) return false;
        int wgid = (int)L; { const int q = nwg / 8, r = nwg % 8, xcd = wgid % 8, off = wgid / 8; wgid = (xcd < r ? xcd * (q + 1) : r * (q + 1) + (xcd - r) * q) + off; }
        const int nig = 8 * nN, gid = wgid / nig, fm = gid * 8, gsz = (nM - fm) < 8 ? (nM - fm) : 8;
        u.pm = fm + ((wgid % nig) % gsz); u.pn = (wgid % nig) / gsz;
        u.A = A + (size_t)u.pm * 256 * K * 2; u.B = B + (size_t)u.pn * 256 * K * 2; u.lst = nullptr; u.gather = 0; u.nvalid = 256; u.aux = 0; u.tb = 0; return true;
    }
};

__device__ __forceinline__ size_t kf_off(int bh, int s, int c  ) { return ((((size_t)bh * 64 + (s >> 5)) * 4 + (c >> 4)) * 64 + ((c >> 3) & 1) * 32 + (s & 31)) * 8; }
__device__ __forceinline__ size_t vf_off(int bh, int s, int d) { const int kr = s & 31; return (((((size_t)bh * 64 + (s >> 5)) * 2 + (d >> 5)) * 2 + (kr >> 4)) * 64 + ((kr >> 2) & 1) * 32 + (d & 31)) * 8 + ((kr >> 3) & 1) * 4 + (kr & 3); }
struct EpiInProj {
    static constexpr bool PERM = true;
    bf16* proj; bf16* kf; bf16* vf;
    __device__ __forceinline__ void operator()(const f32x4 (&acc)[2][2][4][2], const pg8::Unit& u, int wr, int wc, int fr, int fq, LAS unsigned char*) const {
        const int row0 = u.pm * 256 + wr * 64 + fr, col0 = u.pn * 256 + wc * 32 + 8 * fq;
        if (u.pn < 6) {
#pragma unroll
            for (int ai = 0; ai < 2; ++ai)
#pragma unroll
                for (int m = 0; m < 4; ++m) { bf16* rowp = proj + (size_t)(row0 + ai * 128 + m * 16) * 2048 + col0;
#pragma unroll
                    for (int bj = 0; bj < 2; ++bj) { f32x4 v0 = acc[ai][bj][m][0], v1 = acc[ai][bj][m][1];
                        if (u.pn < 4) {
#pragma unroll
                            for (int j = 0; j < 4; ++j) { v0[j] = gelu_fast(v0[j]); v1[j] = gelu_fast(v1[j]); }
                        } else { v0 = v0 * (0.125f * LOG2E); v1 = v1 * (0.125f * LOG2E); }
                        u32x4 w; w.x = cvt_pk_bf16(v0[0], v0[1]); w.y = cvt_pk_bf16(v0[2], v0[3]); w.z = cvt_pk_bf16(v1[0], v1[1]); w.w = cvt_pk_bf16(v1[2], v1[3]);
                        *(u32x4*)(rowp + bj * 128) = w; } }
        } else if (u.pn < 8) {
#pragma unroll
            for (int ai = 0; ai < 2; ++ai)
#pragma unroll
                for (int m = 0; m < 4; ++m) { const int r = row0 + ai * 128 + m * 16, b = r / SEQ, sq = r % SEQ;
#pragma unroll
                    for (int bj = 0; bj < 2; ++bj) { const int hd = col0 + bj * 128 - 1536; const f32x4 v0 = acc[ai][bj][m][0], v1 = acc[ai][bj][m][1];
                        u32x4 w; w.x = cvt_pk_bf16(v0[0], v0[1]); w.y = cvt_pk_bf16(v0[2], v0[3]); w.z = cvt_pk_bf16(v1[0], v1[1]); w.w = cvt_pk_bf16(v1[2], v1[3]);
                        *(u32x4*)(kf + kf_off(b * NH + (hd >> 6), sq, hd & 63)) = w; } }
        } else {
#pragma unroll
            for (int ai = 0; ai < 2; ++ai)
#pragma unroll
                for (int m = 0; m < 4; ++m) { const int r = row0 + ai * 128 + m * 16, b = r / SEQ, sq = r % SEQ;
#pragma unroll
                    for (int bj = 0; bj < 2; ++bj) { const int hd = col0 + bj * 128 - 2048; bf16* dst = vf + vf_off(b * NH + (hd >> 6), sq, hd & 63);
#pragma unroll
                        for (int n = 0; n < 2; ++n)
#pragma unroll
                            for (int j = 0; j < 4; ++j) dst[(4 * n + j) * 8] = f2bf(acc[ai][bj][m][n][j]); } }
        }
    }
};

struct EpiY {
    static constexpr bool PERM = true;
    bf16* C;
    __device__ __forceinline__ void operator()(const f32x4 (&acc)[2][2][4][2], const pg8::Unit& u, int wr, int wc, int fr, int fq, LAS unsigned char*) const {
        const int row0 = u.pm * 256 + wr * 64 + fr, col0 = u.pn * 256 + wc * 32 + 8 * fq;
#pragma unroll
        for (int ai = 0; ai < 2; ++ai)
#pragma unroll
            for (int m = 0; m < 4; ++m) { bf16* rowp = C + (size_t)(row0 + ai * 128 + m * 16) * DM + col0;
#pragma unroll
                for (int bj = 0; bj < 2; ++bj) { const f32x4 v0 = acc[ai][bj][m][0], v1 = acc[ai][bj][m][1];
                    u32x4 w; w.x = cvt_pk_bf16(v0[0], v0[1]); w.y = cvt_pk_bf16(v0[2], v0[3]); w.z = cvt_pk_bf16(v1[0], v1[1]); w.w = cvt_pk_bf16(v1[2], v1[3]);
                    *(u32x4*)(rowp + bj * 128) = w; } }
    }
};
__device__ __forceinline__ int uni(int v) { return __builtin_amdgcn_readfirstlane(v); }
template <class T> __device__ __forceinline__ T* unip(T* p_) { const unsigned long long v = (unsigned long long)p_; const unsigned lo = __builtin_amdgcn_readfirstlane((unsigned)v), hi = __builtin_amdgcn_readfirstlane((unsigned)(v >> 32)); return (T*)(((unsigned long long)hi << 32) | lo); }

struct GTable { LAS const int* pre; LAS const int* lst; LAS const int* cnt; LAS const int* abase; int nent; };
__device__ __forceinline__ bool gt_find(const GTable& T, int L, int& l, int& r) {
    if (L >= T.pre[T.nent]) return false;
    int lo = 0, hi = T.nent;
    while (hi - lo > 1) { const int mid = (lo + hi) >> 1; if (T.pre[mid] <= L) lo = mid; else hi = mid; }
    l = T.lst[lo]; r = L - T.pre[lo]; return true;
}
struct GateUpOrder {
    GTable T; const char* H2; const char* W; const int* list; int G, c;
    __device__ __forceinline__ bool next(int i, pg8::Unit& u) const {
        int e, r; if (!gt_find(T, i * G + c, e, r)) return false;
        e = uni(e); r = uni(r);
        const int tile = r >> 1, pn = r & 1;
        u.pm = e; u.pn = pn; u.aux = uni(T.abase[e]) + tile * 256; u.tb = 0;
        if (e < NE) { u.A = H2; u.lst = list + ((size_t)e * NT + tile * 256) * 2; u.gather = 1; u.nvalid = min(256, uni(T.cnt[e]) - tile * 256); }
        else { u.A = H2 + (size_t)tile * 256 * DM * 2; u.lst = nullptr; u.gather = 0; u.nvalid = 256; }
        u.B = W + ((size_t)e * 512 + pn * 256) * DM * 2; return true;
    }
};
struct DownOrder {
    GTable T; const char* ACT; const char* W; const int* list; int G, c;
    __device__ __forceinline__ bool next(int i, pg8::Unit& u) const {
        int e, r; if (!gt_find(T, i * G + c, e, r)) return false;
        e = uni(e); r = uni(r);
        const int tile = r >> 2, pn = r & 3;
        u.pm = e; u.pn = pn; u.aux = tile * 256; u.gather = 0; u.tb = 0;
        u.A = ACT + ((size_t)uni(T.abase[e]) + tile * 256) * FE * 2;
        if (e < NE) { u.lst = list + ((size_t)e * NT + tile * 256) * 2; u.nvalid = min(256, uni(T.cnt[e]) - tile * 256); } else { u.lst = nullptr; u.nvalid = 256; }
        u.B = W + ((size_t)e * DM + pn * 256) * FE * 2; return true;
    }
};
struct EpiGateUp {
    static constexpr bool PERM = true;
    bf16* act;
    __device__ __forceinline__ void operator()(const f32x4 (&acc)[2][2][4][2], const pg8::Unit& u, int wr, int wc, int fr, int fq, LAS unsigned char* lds) const {
        const int f0 = u.pn * 128 + wc * 16 + 4 * fq;
        const LAS float* tb = (const LAS float*)(lds + u.tb);
#pragma unroll
        for (int ai = 0; ai < 2; ++ai)
#pragma unroll
            for (int m = 0; m < 4; ++m) { const int tr = ai * 128 + wr * 64 + m * 16 + fr; const float w = u.lst ? tb[2 * tr + 1] : 1.f;
                bf16* rowp = act + (size_t)(u.aux + tr) * FE + f0;
#pragma unroll
                for (int bj = 0; bj < 2; ++bj) { const f32x4 g = acc[ai][bj][m][0], up = acc[ai][bj][m][1]; f32x4 a;
#pragma unroll
                    for (int j = 0; j < 4; ++j) a[j] = g[j] * fast_sigmoid(g[j]) * up[j] * w;
                    u32x2 o; o.x = cvt_pk_bf16(a[0], a[1]); o.y = cvt_pk_bf16(a[2], a[3]); *(u32x2*)(rowp + bj * 64) = o; } }
    }
};
constexpr float YP_SCALE = 16.f, YP_MAX = 448.f;
struct EpiDown {
    static constexpr bool PERM = true;
    unsigned char* yp; unsigned char* ys;
    __device__ __forceinline__ void operator()(const f32x4 (&acc)[2][2][4][2], const pg8::Unit& u, int wr, int wc, int fr, int fq, LAS unsigned char* lds) const {
        const int col0 = u.pn * 256 + wc * 32 + 8 * fq;
        const LAS int* tb = (const LAS int*)(lds + u.tb);
        int tk[2][4];
#pragma unroll
        for (int ai = 0; ai < 2; ++ai)
#pragma unroll
            for (int m = 0; m < 4; ++m) tk[ai][m] = u.lst ? tb[2 * (ai * 128 + wr * 64 + m * 16 + fr)] : 0;
#pragma unroll
        for (int ai = 0; ai < 2; ++ai)
#pragma unroll
            for (int m = 0; m < 4; ++m) { const int tr = ai * 128 + wr * 64 + m * 16 + fr;
                unsigned char* rowp = (u.lst ? yp + (size_t)tk[ai][m] * DM : ys + (size_t)(u.aux + tr) * DM) + col0;
#pragma unroll
                for (int bj = 0; bj < 2; ++bj) { f32x4 v0 = acc[ai][bj][m][0] * YP_SCALE, v1 = acc[ai][bj][m][1] * YP_SCALE;
#pragma unroll
                    for (int j = 0; j < 4; ++j) { v0[j] = __builtin_amdgcn_fmed3f(v0[j], -YP_MAX, YP_MAX); v1[j] = __builtin_amdgcn_fmed3f(v1[j], -YP_MAX, YP_MAX); }
                    int w0 = __builtin_amdgcn_cvt_pk_fp8_f32(v0[0], v0[1], 0, false); w0 = __builtin_amdgcn_cvt_pk_fp8_f32(v0[2], v0[3], w0, true);
                    int w1 = __builtin_amdgcn_cvt_pk_fp8_f32(v1[0], v1[1], 0, false); w1 = __builtin_amdgcn_cvt_pk_fp8_f32(v1[2], v1[3], w1, true);
                    if (tr < u.nvalid) *(u32x2*)(rowp + bj * 128) = (u32x2){(unsigned)w0, (unsigned)w1}; } }
    }
};
__device__ __forceinline__ GTable build_table(LAS unsigned char* misc, const int* gcount, int upt) {
    LAS int* pre = (LAS int*)misc; LAS int* lst = pre + 72; LAS int* cnt = lst + 72; LAS int* abase = cnt + 72; LAS int* nent = abase + 72;
    __syncthreads();
    if (threadIdx.x == 0) {
        int ab = 0, ne = 0, pu = 0;
        for (int e = 0; e <= NE; ++e) { const int c_ = e < NE ? gcount[e] : NT; const int ntile = (c_ + 255) >> 8; cnt[e] = c_; abase[e] = ab; ab += ntile * 256;
            if (ntile > 0) { pre[ne] = pu; lst[ne] = e; ++ne; pu += ntile * upt; } }
        pre[ne] = pu; nent[0] = ne;
    }
    __syncthreads();
    GTable T; T.pre = pre; T.lst = lst; T.cnt = cnt; T.abase = abase; T.nent = uni(nent[0]); return T;
}

template <bool NT_ST = false> __device__ __forceinline__ void transpose_item(const float* W, int K, int N, bf16* WT, int mode, LAS float* scr, int item, int lane) {
    const int nblk = N / 32, kb = item / nblk, nb = item % nblk, k0 = 64 * kb, n0 = 32 * nb;
#pragma unroll 8
    for (int i = 0; i < 32; ++i) { const int kk = 2 * i + (lane >> 5); scr[kk * 33 + (lane & 31)] = __builtin_nontemporal_load(W + (size_t)(k0 + kk) * N + n0 + (lane & 31)); }
    asm volatile("s_waitcnt lgkmcnt(0)" ::: "memory");
    const int c = lane & 7;
#pragma unroll
    for (int j = 0; j < 4; ++j) { const int n = (lane >> 3) + 8 * j; const LAS float* s = scr + (8 * c) * 33 + n;
        u32x4 o; o.x = cvt_pk_bf16(s[0 * 33], s[1 * 33]); o.y = cvt_pk_bf16(s[2 * 33], s[3 * 33]); o.z = cvt_pk_bf16(s[4 * 33], s[5 * 33]); o.w = cvt_pk_bf16(s[6 * 33], s[7 * 33]);
        const int nn = n0 + n; const int row = (mode == 0) ? nn : (8 * (nn >> 2) + (nn & 3) + 4 * (mode - 1));
        if (NT_ST) __builtin_nontemporal_store(o, (u32x4*)(WT + (size_t)row * K + k0 + 8 * c)); else *(GAS u32x4*)(WT + (size_t)row * K + k0 + 8 * c) = o; }
    asm volatile("s_waitcnt lgkmcnt(0)" ::: "memory");
}


typedef GAS unsigned gu32;
#define XB_TMO      128
#define XB_XCNT(j)  (256  + 64 * (j))
#define XB_XSUB(j)  (1280 + 64 * (j))
#define XB_XGEN(j)  (2304 + 64 * (j))
#define XB_TOP      3328
#define XB_TOPGEN   3392
#define XCD_BAR_WORDS 3456
#define XB_SPIN_CAP (1u << 18)
constexpr int CW_BAR = 4096;
__device__ __forceinline__ unsigned xb_ld(unsigned* p)              { return __hip_atomic_load(p, __ATOMIC_RELAXED, __HIP_MEMORY_SCOPE_AGENT); }
__device__ __forceinline__ unsigned xb_add(unsigned* p, unsigned v) { return __hip_atomic_fetch_add(p, v, __ATOMIC_RELAXED, __HIP_MEMORY_SCOPE_AGENT); }
__device__ __forceinline__ unsigned xb_xcc_id() { return (unsigned)__builtin_amdgcn_s_getreg((3 << 11) | 20) & 0xFu; }
#define XB_SPIN(cond, bar) do { unsigned _sp = 0; while (cond) { __builtin_amdgcn_s_sleep(1); \
    if ((++_sp & 255u) == 0u) { if (xb_ld(&(bar)[XB_TMO])) break; if (_sp > XB_SPIN_CAP) { atomicAdd(&(bar)[XB_TMO], 1u); break; } } } } while (0)
struct XcdBarrier { unsigned* bar; unsigned x; volatile LAS unsigned* st; };
__device__ __forceinline__ XcdBarrier xcd_barrier_post(unsigned* bar, volatile LAS unsigned* st) {
    XcdBarrier b; b.bar = bar; b.x = xb_xcc_id(); b.st = st;
    if (threadIdx.x == 0) (void)xb_add(&bar[XB_XCNT(b.x)], 1u);
    return b;
}
__device__ __forceinline__ void xcd_barrier_complete(unsigned* bar, unsigned x, unsigned& nloc, unsigned& nx) {
    const unsigned G = gridDim.x * gridDim.y * gridDim.z;
    unsigned sum, cnt, mine, sp = 0u;
    for (;;) {
        sum = 0u; cnt = 0u; mine = 0u;
#pragma unroll
        for (unsigned j = 0; j < 16; ++j) { const unsigned c = xb_ld(&bar[XB_XCNT(j)]); sum += c; cnt += (c > 0u) ? 1u : 0u; mine = (j == x) ? c : mine; }
        if (sum == G) break;
        __builtin_amdgcn_s_sleep(1);
        if ((++sp & 255u) == 0u) { if (xb_ld(&bar[XB_TMO])) break; if (sp > XB_SPIN_CAP) { atomicAdd(&bar[XB_TMO], 1u); break; } }
    }
    nloc = mine > 0u ? mine : 1u; nx = cnt > 0u ? cnt : 1u;
}
__device__ __forceinline__ void xcd_barrier(const XcdBarrier& b) {
    asm volatile("s_waitcnt vmcnt(0)" ::: "memory");
    __syncthreads();
    if (threadIdx.x == 0) {
        unsigned* bar = b.bar;
        __builtin_amdgcn_s_waitcnt(0);
        unsigned nloc = b.st[0], nx = b.st[1];
        if (nloc == 0u) { xcd_barrier_complete(bar, b.x, nloc, nx); b.st[0] = nloc; b.st[1] = nx; }
        const unsigned old = xb_add(&bar[XB_XSUB(b.x)], 1u);
        const unsigned gen = old / nloc;
        if (old + 1u == (gen + 1u) * nloc) {
            __builtin_amdgcn_fence(__ATOMIC_RELEASE, "agent");
            asm volatile("s_waitcnt vmcnt(0)" ::: "memory");
            const unsigned og = xb_add(&bar[XB_TOP], 1u);
            const unsigned tg = og / nx;
            if (og + 1u == (tg + 1u) * nx) xb_add(&bar[XB_TOPGEN], 1u);
            else XB_SPIN(xb_ld(&bar[XB_TOPGEN]) == tg, bar);
            __builtin_amdgcn_fence(__ATOMIC_ACQUIRE, "agent");
            xb_add(&bar[XB_XGEN(b.x)], 1u);
            asm volatile("s_waitcnt vmcnt(0)" ::: "memory");
        } else {
            XB_SPIN(xb_ld(&bar[XB_XGEN(b.x)]) == gen, bar);
            __builtin_amdgcn_fence(__ATOMIC_ACQUIRE, "agent");
            asm volatile("s_waitcnt vmcnt(0)" ::: "memory");
        }
    }
    __syncthreads();
}

#ifndef REP_PH
#define REP_PH -1
#endif
#ifndef REP_N
#define REP_N 1
#endif
struct MArgs { P p; int ph_lo, ph_hi, dbg, pad; };

__global__ void __launch_bounds__(NTHR, 2) mega(MArgs a) {
    extern __shared__ __attribute__((aligned(16))) unsigned char lds_raw[];
    LAS unsigned char* lds = (LAS unsigned char*)lds_raw;
    const P& p = a.p;
    const int tid = threadIdx.x, lane = tid & 63, wave = __builtin_amdgcn_readfirstlane(tid >> 6);
    const int G = gridDim.x, bx = blockIdx.x, vcu = (G % 8 == 0) ? (bx % 8) * (G / 8) + bx / 8 : bx;
    unsigned char* ws = p.ws;
    float* const outw = a.dbg ? (float*)(ws + WS_RB) : p.out;
    volatile LAS unsigned* bst = (volatile LAS unsigned*)(lds + LDS_MISC + 8192);
    if (tid < 2) bst[tid] = 0u;
    __syncthreads();
    XcdBarrier xbar = xcd_barrier_post((unsigned*)(ws + WS_CTL) + CW_BAR, bst);
#define IN(k) (a.ph_lo <= (k) && (k) < a.ph_hi)
#define SEAM(k) do { if (IN(k) && IN((k) + 1)) xcd_barrier(xbar); } while (0)

    if (IN(0)) for (int rep_ = 0; rep_ < (REP_PH == 0 ? REP_N : 1); ++rep_) { __syncthreads();
        if (rep_ == 0) {
            LAS float* sc = (LAS float*)(lds);
            LAS float* part = (LAS float*)(lds + 32768);
            for (int i = tid; i < NB * DM; i += NTHR) { const float cv = p.c[i]; sc[i] = cv * fast_sigmoid(cv); }
            for (int cb = bx; cb < 256; cb += G) {
                __syncthreads();
                const int kg = tid >> 3, cq = tid & 7, n0 = cb * 24 + cq * 3;
                float acc[8][3];
#pragma unroll
                for (int b2 = 0; b2 < 8; ++b2) { acc[b2][0] = 0.f; acc[b2][1] = 0.f; acc[b2][2] = 0.f; }
                float w[16][3];
#pragma unroll
                for (int r = 0; r < 16; ++r) { const float* wp = p.w_ada + (size_t)(kg * 16 + r) * 6144 + n0; w[r][0] = __builtin_nontemporal_load(wp); w[r][1] = __builtin_nontemporal_load(wp + 1); w[r][2] = __builtin_nontemporal_load(wp + 2); }
#pragma unroll
                for (int r = 0; r < 16; ++r)
#pragma unroll
                    for (int b2 = 0; b2 < 8; ++b2) { const float sv = sc[b2 * DM + kg * 16 + r]; acc[b2][0] += sv * w[r][0]; acc[b2][1] += sv * w[r][1]; acc[b2][2] += sv * w[r][2]; }
#pragma unroll
                for (int b2 = 0; b2 < 8; ++b2)
#pragma unroll
                    for (int j = 0; j < 3; ++j) part[(kg * 8 + b2) * 24 + cq * 3 + j] = acc[b2][j];
                __syncthreads();
                if (tid < 192) { const int b2 = tid / 24, j = tid % 24; float sum = p.b_ada[cb * 24 + j];
                    for (int g2 = 0; g2 < 64; ++g2) sum += part[(g2 * 8 + b2) * 24 + j];
                    ((float*)(ws + WS_MOD))[b2 * 6144 + cb * 24 + j] = sum; }
            }
        }
        __syncthreads();
        for (int i = bx * NTHR + tid; i < NE * DM; i += G * NTHR) { const int e = i / DM, k = i % DM; const float w = p.w_router[(size_t)k * NE + e]; const bf16 hi = f2bf(w);
            bf16* wrt = (bf16*)(ws + WS_WRT); wrt[i] = hi; wrt[NE * DM + i] = f2bf(w - bf2f(hi)); }
        for (int i = bx * NTHR + tid; i < 4 * 128 * 128; i += G * NTHR) ((bf16*)(ws + WS_WSP))[i] = f2bf(p.w_sp[i]);
        LAS float* scr = (LAS float*)(lds + wave * 16384);
        const int gw = vcu * NWAVES + wave, NGW = G * NWAVES;
        constexpr int I_IN = 16 * 80, I_OUT = 16 * 32, I_G = 16 * 8, I_D = 4 * 32;
        constexpr int NITEMS = I_IN + I_OUT + 65 * 2 * I_G + (65 - LATE_DOWN) * I_D;
        for (int it = gw; it < NITEMS; it += NGW) {
            int r = it;
            if (r < I_IN) { transpose_item(p.w_in, DM, 2560, (bf16*)(ws + WS_WINT), 0, scr, r, lane); continue; } r -= I_IN;
            if (r < I_OUT) { transpose_item(p.w_out, DM, DM, (bf16*)(ws + WS_WOUTT), 0, scr, r, lane); continue; } r -= I_OUT;
            if (r < 65 * 2 * I_G) { const int e = r / (2 * I_G); r -= e * (2 * I_G); const int up = r >= I_G; if (up) r -= I_G;
                transpose_item<true>(e < 64 ? (up ? p.w_up : p.w_gate) + (size_t)e * DM * FE : (up ? p.ws_up : p.ws_gate), DM, FE, (bf16*)(ws + WS_WGUT) + (size_t)e * 512 * DM, 1 + up, scr, r, lane); continue; }
            r -= 65 * 2 * I_G;
            const int e = LATE_DOWN + r / I_D; r %= I_D;
            transpose_item<true>(e < 64 ? p.w_down + (size_t)e * FE * DM : p.ws_down, FE, DM, (bf16*)(ws + WS_WDT) + (size_t)e * DM * FE, 0, scr, r, lane);
        }
    }
    SEAM(0);
    if (IN(1)) for (int rep_ = 0; rep_ < (REP_PH == 1 ? REP_N : 1); ++rep_) { __syncthreads();
        const int gw = vcu * NWAVES + wave, NGW = G * NWAVES;
        bf16* h1 = (bf16*)(ws + WS_RA);
        for (int t0 = gw; t0 < NT; t0 += 2 * NGW) {
            f32x4 v[2][4]; float s[2];
#pragma unroll
            for (int q = 0; q < 2; ++q) { const int t = min(t0 + q * NGW, NT - 1); const f32x4* xr = (const f32x4*)(p.x + (size_t)t * DM) + lane; s[q] = 0.f;
#pragma unroll
                for (int j = 0; j < 4; ++j) { v[q][j] = xr[64 * j]; s[q] += (v[q][j].x * v[q][j].x + v[q][j].y * v[q][j].y) + (v[q][j].z * v[q][j].z + v[q][j].w * v[q][j].w); } }
#pragma unroll
            for (int q = 0; q < 2; ++q) { const int t = t0 + q * NGW; if (t >= NT) break;
                const int b = t / SEQ; const float* mod = (const float*)(ws + WS_MOD) + b * 6144;
                const float rstd = rsqrtf(wave_sum(s[q]) * (1.f / DM) + EPS);
                u32x2* o8 = (u32x2*)(h1 + (size_t)t * DM) + lane;
#pragma unroll
                for (int j = 0; j < 4; ++j) { const int k = 4 * lane + 256 * j;
                    const f32x4 g = *(const f32x4*)(p.g_pre_mix + k), s1 = *(const f32x4*)(mod + 1024 + k), h = *(const f32x4*)(mod + k);
                    const f32x4 r = v[q][j] * rstd * g * (1.f + s1) + h;
                    u32x2 w; w.x = cvt_pk_bf16(r.x, r.y); w.y = cvt_pk_bf16(r.z, r.w); o8[64 * j] = w; } }
        }
    }
    SEAM(1);
    if (IN(2)) for (int rep_ = 0; rep_ < (REP_PH == 2 ? REP_N : 1); ++rep_) { __syncthreads();
        DenseOrder S; S.init(ws + WS_RA, ws + WS_WINT, NT, 2560, DM, G, bx);
        EpiInProj E{(bf16*)(ws + WS_RB), (bf16*)(ws + WS_KF), (bf16*)(ws + WS_VT)};
        pg8::gemm_phase<EpiInProj, DenseOrder>(lds, DM, S, E);
        { const int nfull = 640 / G, nrem = 640 % G;
          if (nrem > 0 && bx >= nrem) { __syncthreads();
              LAS float* scr = (LAS float*)(lds + wave * 16384);
              const int lw = (bx - nrem) * NWAVES + wave, nlw = (G - nrem) * NWAVES;
              for (int it = lw; it < LATE_DOWN * 128; it += nlw) { const int e = it / 128, r = it % 128;
                  transpose_item<true>(p.w_down + (size_t)e * FE * DM, FE, DM, (bf16*)(ws + WS_WDT) + (size_t)e * DM * FE, 0, scr, r, lane); } }
          else if (nrem == 0) { __syncthreads();
              LAS float* scr = (LAS float*)(lds + wave * 16384);
              for (int it = bx * NWAVES + wave; it < LATE_DOWN * 128; it += G * NWAVES) { const int e = it / 128, r = it % 128;
                  transpose_item<true>(p.w_down + (size_t)e * FE * DM, FE, DM, (bf16*)(ws + WS_WDT) + (size_t)e * DM * FE, 0, scr, r, lane); } }
          (void)nfull; }
    }


    SEAM(2);
    if (IN(3)) for (int rep_ = 0; rep_ < (REP_PH == 3 ? REP_N : 1); ++rep_) { __syncthreads();
        const bf16* proj = (const bf16*)(ws + WS_RB); const bf16* vt = (const bf16*)(ws + WS_VT); const bf16* kfm = (const bf16*)(ws + WS_KF); bf16* mixed = (bf16*)(ws + WS_RA);
        LAS float* ssqs = (LAS float*)lds;
        const int r32 = lane & 31, hi = lane >> 5, h = wave;
        for (int unit = vcu; unit < 256; unit += G) {
            const int b = unit >> 5, pi = unit & 31;
#pragma unroll 1
            for (int uu = 0; uu < 2; ++uu) {
                const int qb = uu == 0 ? pi : 63 - pi, q0 = qb * 32;
                const bf16* qp = proj + (size_t)(b * SEQ + q0 + r32) * 2048 + 1024 + h * HD + hi * 8;
                bf16x8 qr[4];
#pragma unroll
                for (int d0 = 0; d0 < 4; ++d0) qr[d0] = *(const bf16x8*)(qp + d0 * 16);
                f32x16 o0, o1;
#pragma unroll
                for (int r = 0; r < 16; ++r) { o0[r] = 0.f; o1[r] = 0.f; }
                float carry = 1.f;
                const bf16* kbase = kfm + (size_t)(b * NH + h) * 64 * 2048 + lane * 8;
                const bf16* vbase = vt + (size_t)(b * NH + h) * 64 * 2048 + lane * 8;
                bf16x8 kA[4], kB[4], kC[4], vA[2][2], vB[2][2], vC[2][2];
#define ATT_LOAD(KF, VF, kv0_) do { const size_t o_ = (size_t)((kv0_) >> 5) * 2048; _Pragma("unroll") for (int d0 = 0; d0 < 4; ++d0) KF[d0] = *(const bf16x8*)(kbase + o_ + d0 * 512); \
                    _Pragma("unroll") for (int db = 0; db < 2; ++db) _Pragma("unroll") for (int ss = 0; ss < 2; ++ss) VF[db][ss] = *(const bf16x8*)(vbase + o_ + (db * 2 + ss) * 512); } while (0)
#define ATT_STEP(KF, VF, KP, VP, kb_) do { const int kv0 = (kb_) * 32; \
                    ATT_LOAD(KP, VP, ((kb_) >= 2 ? kv0 - 64 : 0)); \
                    f32x16 pz; _Pragma("unroll") for (int r = 0; r < 16; ++r) pz[r] = 0.f; \
                    _Pragma("unroll") for (int d0 = 0; d0 < 4; ++d0) pz = MFMA32(KF[d0], qr[d0], pz); \
                    if ((kb_) == qb) sb_tile(pz, carry, true, kv0 + 4 * hi - (q0 + r32), hi); else sb_tile(pz, carry, false, 0, hi); \
                    _Pragma("unroll") for (int sstep = 0; sstep < 2; ++sstep) { \
                        u32x4 pk; pk.x = cvtpk(pz[8 * sstep + 0], pz[8 * sstep + 1]); pk.y = cvtpk(pz[8 * sstep + 2], pz[8 * sstep + 3]); pk.z = cvtpk(pz[8 * sstep + 4], pz[8 * sstep + 5]); pk.w = cvtpk(pz[8 * sstep + 6], pz[8 * sstep + 7]); \
                        const bf16x8 xs = __builtin_bit_cast(bf16x8, pk); \
                        o0 = MFMA32(VF[0][sstep], xs, o0); o1 = MFMA32(VF[1][sstep], xs, o1); } \
                      \
                    done = (kb_) == 0 || __all(carry == 0.f); } while (0)
                ATT_LOAD(kA, vA, q0); ATT_LOAD(kB, vB, (qb >= 1 ? q0 - 32 : 0));
                bool done = false;
#pragma unroll 1
                for (int kb = qb; ; kb -= 3) {
                    ATT_STEP(kA, vA, kC, vC, kb); if (done) break;
                    ATT_STEP(kB, vB, kA, vA, kb - 1); if (done) break;
                    ATT_STEP(kC, vC, kB, vB, kb - 2); if (done) break;
                }
#undef ATT_STEP
#undef ATT_LOAD
                float sq = 0.f;
#pragma unroll
                for (int r = 0; r < 16; ++r) sq += o0[r] * o0[r] + o1[r] * o1[r];
                sq += __shfl_xor(sq, 32);
                __syncthreads();
                if (hi == 0) ssqs[h * 32 + r32] = sq;
                __syncthreads();
                float tot = 0.f;
#pragma unroll
                for (int w2 = 0; w2 < 8; ++w2) tot += ssqs[w2 * 32 + r32];
                const float rstd = rsqrtf(tot * (1.f / DSB) + EPS);
                bf16* op = mixed + (size_t)(b * SEQ + q0 + r32) * DM + 512 + h * HD + 4 * hi;
                const float* gb = p.g_branch + 512 + h * HD + 4 * hi;
#pragma unroll
                for (int g4 = 0; g4 < 4; ++g4) {
                    const f32x4 ga = *(const f32x4*)(gb + 8 * g4), gc = *(const f32x4*)(gb + 32 + 8 * g4);
                    u32x2 w0, w1;
                    w0.x = cvtpk(o0[4 * g4] * rstd * ga.x, o0[4 * g4 + 1] * rstd * ga.y); w0.y = cvtpk(o0[4 * g4 + 2] * rstd * ga.z, o0[4 * g4 + 3] * rstd * ga.w);
                    w1.x = cvtpk(o1[4 * g4] * rstd * gc.x, o1[4 * g4 + 1] * rstd * gc.y); w1.y = cvtpk(o1[4 * g4 + 2] * rstd * gc.z, o1[4 * g4 + 3] * rstd * gc.w);
                    *(u32x2*)(op + 8 * g4) = w0; *(u32x2*)(op + 32 + 8 * g4) = w1; }
            }
        }
    }
    __syncthreads();
    if (IN(4)) for (int rep_ = 0; rep_ < (REP_PH == 4 ? REP_N : 1); ++rep_) { __syncthreads();
        constexpr int RS = 1040;
        const bf16* proj = (const bf16*)(ws + WS_RB); const bf16* wsp = (const bf16*)(ws + WS_WSP); bf16* mixed = (bf16*)(ws + WS_RA);
        LAS unsigned char* VN = lds; LAS float* ssq = (LAS float*)(lds + 128 * RS);
        const int r32 = lane & 31, hi = lane >> 5;
        for (int unit = vcu; unit < 256; unit += G) {
            const int ih = unit & 1, t0 = (unit >> 1) * 128, nj = 64 * (ih + 1);
            __syncthreads();
            const f32x4 lg0 = *(const f32x4*)(p.ln_g + 8 * lane), lg1 = *(const f32x4*)(p.ln_g + 8 * lane + 4), lb0 = *(const f32x4*)(p.ln_b + 8 * lane), lb1 = *(const f32x4*)(p.ln_b + 8 * lane + 4);
#pragma unroll 1
            for (int j0 = wave; j0 < nj; j0 += 32) {
                u32x4 raw4[4];
#pragma unroll
                for (int q = 0; q < 4; ++q) raw4[q] = *(const u32x4*)(proj + (size_t)(t0 + min(j0 + 8 * q, nj - 1)) * 2048 + 512 + 8 * lane);
#pragma unroll
                for (int q = 0; q < 4; ++q) { const int j = j0 + 8 * q; const u32x4 raw = raw4[q];
                    float v[8] = {bflo(raw.x), bfhi(raw.x), bflo(raw.y), bfhi(raw.y), bflo(raw.z), bfhi(raw.z), bflo(raw.w), bfhi(raw.w)};
                    float sm = 0.f;
#pragma unroll
                    for (int i = 0; i < 8; ++i) sm += v[i];
                    const float mu = wave_sum(sm) * (1.f / DG); float q2 = 0.f;
#pragma unroll
                    for (int i = 0; i < 8; ++i) { v[i] -= mu; q2 += v[i] * v[i]; }
                    const float rstd = rsqrtf(wave_sum(q2) * (1.f / DG) + EPS);
                    u32x4 o; o.x = cvtpk(v[0] * rstd * lg0.x + lb0.x, v[1] * rstd * lg0.y + lb0.y); o.y = cvtpk(v[2] * rstd * lg0.z + lb0.z, v[3] * rstd * lg0.w + lb0.w);
                    o.z = cvtpk(v[4] * rstd * lg1.x + lb1.x, v[5] * rstd * lg1.y + lb1.y); o.w = cvtpk(v[6] * rstd * lg1.z + lb1.z, v[7] * rstd * lg1.w + lb1.w);
                    if (j < nj) *(LAS u32x4*)(VN + j * RS + lane * 16) = o; }
            }
            __syncthreads();
            const int g = wave >> 1, ch0 = g * 128 + (wave & 1) * 64;
            f32x16 acc[2][2];
#pragma unroll
            for (int ct = 0; ct < 2; ++ct)
#pragma unroll
                for (int it = 0; it < 2; ++it)
#pragma unroll
                    for (int r = 0; r < 16; ++r) acc[ct][it][r] = 0.f;
#pragma unroll 1
            for (int sstep = 0; sstep < nj / 16; ++sstep) {
                bf16x8 af[2], bw[2];
#pragma unroll
                for (int ct = 0; ct < 2; ++ct)
#pragma unroll
                    for (int jj = 0; jj < 8; ++jj) af[ct][jj] = *(const LAS short*)(VN + (16 * sstep + 8 * hi + jj) * RS + (ch0 + ct * 32 + r32) * 2);
#pragma unroll
                for (int it = 0; it < 2; ++it) bw[it] = *(const bf16x8*)(wsp + (size_t)(g * 128 + 64 * ih + 32 * it + r32) * 128 + 16 * sstep + 8 * hi);
#pragma unroll
                for (int ct = 0; ct < 2; ++ct)
#pragma unroll
                    for (int it = 0; it < 2; ++it) acc[ct][it] = MFMA32(af[ct], bw[it], acc[ct][it]);
            }
            float sq[2];
#pragma unroll
            for (int it = 0; it < 2; ++it) { const int i = 64 * ih + 32 * it + r32; const float bs = p.b_sp[g * 128 + i]; sq[it] = 0.f;
                const bf16* up = proj + (size_t)(t0 + i) * 2048 + ch0 + 4 * hi;
#pragma unroll
                for (int ct = 0; ct < 2; ++ct)
#pragma unroll
                    for (int g4 = 0; g4 < 4; ++g4) { const u32x2 uu2 = *(const u32x2*)(up + ct * 32 + 8 * g4);
                        const float u0 = bflo(uu2.x), u1 = bfhi(uu2.x), u2 = bflo(uu2.y), u3 = bfhi(uu2.y);
                        float a0 = u0 * (acc[ct][it][4 * g4] + bs), a1 = u1 * (acc[ct][it][4 * g4 + 1] + bs), a2 = u2 * (acc[ct][it][4 * g4 + 2] + bs), a3 = u3 * (acc[ct][it][4 * g4 + 3] + bs);
                        acc[ct][it][4 * g4] = a0; acc[ct][it][4 * g4 + 1] = a1; acc[ct][it][4 * g4 + 2] = a2; acc[ct][it][4 * g4 + 3] = a3;
                        sq[it] += (a0 * a0 + a1 * a1) + (a2 * a2 + a3 * a3); }
                sq[it] += __shfl_xor(sq[it], 32);
                if (hi == 0) ssq[wave * 64 + it * 32 + r32] = sq[it]; }
            __syncthreads();
#pragma unroll
            for (int it = 0; it < 2; ++it) { const int i = 64 * ih + 32 * it + r32; float tot = 0.f;
#pragma unroll
                for (int w2 = 0; w2 < 8; ++w2) tot += ssq[w2 * 64 + it * 32 + r32];
                const float rstd = rsqrtf(tot * (1.f / DG) + EPS);
                bf16* op = mixed + (size_t)(t0 + i) * DM + ch0 + 4 * hi;
#pragma unroll
                for (int ct = 0; ct < 2; ++ct)
#pragma unroll
                    for (int g4 = 0; g4 < 4; ++g4) { const f32x4 gb = *(const f32x4*)(p.g_branch + ch0 + 4 * hi + ct * 32 + 8 * g4);
                        u32x2 w; w.x = cvtpk(acc[ct][it][4 * g4] * rstd * gb.x, acc[ct][it][4 * g4 + 1] * rstd * gb.y); w.y = cvtpk(acc[ct][it][4 * g4 + 2] * rstd * gb.z, acc[ct][it][4 * g4 + 3] * rstd * gb.w);
                        *(u32x2*)(op + ct * 32 + 8 * g4) = w; } }
        }
    }
    SEAM(4);
    if (IN(5)) for (int rep_ = 0; rep_ < (REP_PH == 5 ? REP_N : 1); ++rep_) { __syncthreads();
        DenseOrder S; S.init(ws + WS_RA, ws + WS_WOUTT, NT, DM, DM, G, bx);
        EpiY E{(bf16*)(ws + WS_RB)};
        pg8::gemm_phase<EpiY, DenseOrder>(lds, DM, S, E);
    }
    SEAM(5);
    if (IN(6)) for (int rep_ = 0; rep_ < (REP_PH == 6 ? REP_N : 1); ++rep_) { __syncthreads();
        LAS float* part = (LAS float*)lds;
        LAS int* lcnt = (LAS int*)(lds + 131072);
        LAS int* lbase = lcnt + 64;
        LAS int* lent = lbase + 64;
        int* gcount = (int*)(ws + WS_CTL) + CTL_GCOUNT;
        int* list = (int*)(ws + WS_LIST);
        const bf16* wrt = (const bf16*)(ws + WS_WRT);
        bf16* h2g = (bf16*)(ws + WS_RA); bf16* h2l = (bf16*)(ws + WS_OSB);
        const int fr = lane & 15, fq = lane >> 4;
        for (int base = vcu * 64; base < NT; base += G * 64) {
            __syncthreads();
            if (tid < 64) lcnt[tid] = 0;
#pragma unroll 1
            for (int rr = 0; rr < 8; rr += 2) {
                f32x4 yv[2][4], xv[2][4]; float s[2];
#pragma unroll
                for (int q = 0; q < 2; ++q) { const int t = base + wave * 8 + rr + q; s[q] = 0.f;
                    const u32x2* yr = (const u32x2*)((const bf16*)(ws + WS_RB) + (size_t)t * DM) + lane; const f32x4* xr = (const f32x4*)(p.x + (size_t)t * DM) + lane;
#pragma unroll
                    for (int j = 0; j < 4; ++j) { const u32x2 yb = yr[64 * j]; yv[q][j] = (f32x4){bflo(yb.x), bfhi(yb.x), bflo(yb.y), bfhi(yb.y)}; xv[q][j] = __builtin_nontemporal_load(xr + 64 * j);
                        s[q] += (yv[q][j].x * yv[q][j].x + yv[q][j].y * yv[q][j].y) + (yv[q][j].z * yv[q][j].z + yv[q][j].w * yv[q][j].w); } }
#pragma unroll
                for (int q = 0; q < 2; ++q) { const int t = base + wave * 8 + rr + q, b = t / SEQ; const float* mod = (const float*)(ws + WS_MOD) + b * 6144;
                    const float ry = rsqrtf(wave_sum(s[q]) * (1.f / DM) + EPS); float s2 = 0.f;
#pragma unroll
                    for (int j = 0; j < 4; ++j) { const int k = 4 * lane + 256 * j;
                        const f32x4 gp = *(const f32x4*)(p.g_post_mix + k), ga = *(const f32x4*)(mod + 2048 + k);
                        xv[q][j] = xv[q][j] + ga * (yv[q][j] * ry * gp);
                        *((f32x4*)(outw + (size_t)t * DM) + lane + 64 * j) = xv[q][j];
                        s2 += (xv[q][j].x * xv[q][j].x + xv[q][j].y * xv[q][j].y) + (xv[q][j].z * xv[q][j].z + xv[q][j].w * xv[q][j].w); }
                    const float rx = rsqrtf(wave_sum(s2) * (1.f / DM) + EPS);
#pragma unroll
                    for (int j = 0; j < 4; ++j) { const int k = 4 * lane + 256 * j;
                        const f32x4 gf = *(const f32x4*)(p.g_pre_ffn + k), sc2 = *(const f32x4*)(mod + 4096 + k), h0 = *(const f32x4*)(mod + 3072 + k);
                        const f32x4 h = xv[q][j] * rx * gf * (1.f + sc2) + h0;
                        u32x2 hi; hi.x = cvtpk(h.x, h.y); hi.y = cvtpk(h.z, h.w);
                        const f32x4 d = h - (f32x4){bflo(hi.x), bfhi(hi.x), bflo(hi.y), bfhi(hi.y)}; u32x2 lo; lo.x = cvtpk(d.x, d.y); lo.y = cvtpk(d.z, d.w);
                        *((u32x2*)(h2g + (size_t)t * DM) + lane + 64 * j) = hi; *((u32x2*)(h2l + (size_t)t * DM) + lane + 64 * j) = lo; } }
            }
            asm volatile("s_waitcnt vmcnt(0)" ::: "memory");
            __syncthreads();
            { f32x4 ac[4][4];
#pragma unroll
              for (int mt = 0; mt < 4; ++mt)
#pragma unroll
                  for (int nt = 0; nt < 4; ++nt) ac[mt][nt] = (f32x4){0.f, 0.f, 0.f, 0.f};
              const size_t ao = (size_t)(base + fr) * DM + 128 * wave + 8 * fq; const bf16* bp = wrt + (size_t)fr * DM + 128 * wave + 8 * fq;
#pragma unroll 1
              for (int ks = 0; ks < 4; ++ks) {
                  bf16x8 ah[4], al[4], bh[4], bl[4];
#pragma unroll
                  for (int mt = 0; mt < 4; ++mt) { ah[mt] = *(const bf16x8*)(h2g + ao + (size_t)mt * 16 * DM + 32 * ks); al[mt] = *(const bf16x8*)(h2l + ao + (size_t)mt * 16 * DM + 32 * ks); }
#pragma unroll
                  for (int nt = 0; nt < 4; ++nt) { bh[nt] = *(const bf16x8*)(bp + (size_t)nt * 16 * DM + 32 * ks); bl[nt] = *(const bf16x8*)(bp + (size_t)(64 + nt * 16) * DM + 32 * ks); }
#pragma unroll
                  for (int mt = 0; mt < 4; ++mt)
#pragma unroll
                      for (int nt = 0; nt < 4; ++nt) { ac[mt][nt] = __builtin_amdgcn_mfma_f32_16x16x32_bf16(ah[mt], bh[nt], ac[mt][nt], 0, 0, 0);
                          ac[mt][nt] = __builtin_amdgcn_mfma_f32_16x16x32_bf16(al[mt], bh[nt], ac[mt][nt], 0, 0, 0); ac[mt][nt] = __builtin_amdgcn_mfma_f32_16x16x32_bf16(ah[mt], bl[nt], ac[mt][nt], 0, 0, 0); } }
#pragma unroll
              for (int mt = 0; mt < 4; ++mt)
#pragma unroll
                  for (int nt = 0; nt < 4; ++nt)
#pragma unroll
                      for (int r = 0; r < 4; ++r) part[(wave * 64 + mt * 16 + 4 * fq + r) * 64 + nt * 16 + fr] = ac[mt][nt][r];
            }
            __syncthreads();
            const float rbias = p.router_bias[lane];
#pragma unroll 2
            for (int rr = 0; rr < 8; ++rr) {
                const int tl = wave * 8 + rr, t = base + tl;
                float lgt = 0.f;
#pragma unroll
                for (int w2 = 0; w2 < 8; ++w2) lgt += part[(w2 * 64 + tl) * 64 + lane];
                const float sg = __builtin_amdgcn_rcpf(1.f + __expf(-lgt)); const float bi = sg + rbias;
                const float m1 = group8_max(bi);
                const unsigned gb = (unsigned)(__ballot(bi == m1) >> (lane & ~7)) & 0xffu;
                const int first = __builtin_ctz(gb);
                const float m2 = group8_max((lane & 7) == first ? -INFINITY : bi);
                const float gs = m1 + m2; const int g = lane >> 3; int grank = 0;
#pragma unroll
                for (int g2 = 0; g2 < 8; ++g2) { const float v = rdlane(gs, g2 * 8); grank += (v > gs || (v == gs && g2 < g)) ? 1 : 0; }
                const bool gsel = grank < TKG; const float mk = gsel ? bi : -INFINITY;
                float cur = mk; bool sel = false; int slot = 0;
#pragma unroll
                for (int r = 0; r < TOPK; ++r) {
                    float v = cur; v = __builtin_fmaxf(v, dppf<0xB1>(v)); v = __builtin_fmaxf(v, dppf<0x4E>(v)); v = __builtin_fmaxf(v, dppf<0x141>(v)); v = __builtin_fmaxf(v, dppf<0x140>(v));
                    const float mx = __builtin_fmaxf(__builtin_fmaxf(rdlane(v, 0), rdlane(v, 16)), __builtin_fmaxf(rdlane(v, 32), rdlane(v, 48)));
                    const int first = __builtin_ctzll(__ballot(cur == mx));
                    if (lane == first) { sel = true; slot = r; cur = -INFINITY; }
                }
                const float wsum = wave_sum(sel ? sg : 0.f);
                if (sel) { const float w = sg / wsum * ROUTED_SCALE; const int tk = t * 8 + slot, l = lane;
                    const int pos = __hip_atomic_fetch_add(lcnt + l, 1, __ATOMIC_RELAXED, __HIP_MEMORY_SCOPE_WORKGROUP);
                    const int ei = tl * 8 + slot; lent[ei * 2 + 0] = (int)((unsigned)l | ((unsigned)pos << 6) | ((unsigned)tk << 15)); lent[ei * 2 + 1] = __builtin_bit_cast(int, w); }
            }
            __syncthreads();
            if (tid < 64) lbase[tid] = (lcnt[tid] && !a.dbg) ? atomicAdd(gcount + tid, lcnt[tid]) : 0;
            __syncthreads();
            { const unsigned pk = (unsigned)lent[tid * 2 + 0]; const int l = pk & 63u, pos = (pk >> 6) & 511u; if (!a.dbg) *(u32x2*)(list + ((size_t)l * NT + lbase[l] + pos) * 2) = (u32x2){pk >> 15, (unsigned)lent[tid * 2 + 1]}; }
        }
    }
    SEAM(6);
    if (IN(7)) for (int rep_ = 0; rep_ < (REP_PH == 7 ? REP_N : 1); ++rep_) { __syncthreads();
        const int* gcount = (const int*)(ws + WS_CTL) + CTL_GCOUNT;
        GateUpOrder S; S.T = build_table(lds + LDS_MISC, gcount, 2); S.H2 = (const char*)(ws + WS_RA); S.W = (const char*)(ws + WS_WGUT); S.list = (const int*)(ws + WS_LIST); S.G = G; S.c = vcu;
        EpiGateUp E{(bf16*)(ws + WS_RB)};
        pg8::gemm_phase<EpiGateUp, GateUpOrder>(lds, DM, S, E);
    }
    SEAM(7);
    if (IN(8)) for (int rep_ = 0; rep_ < (REP_PH == 8 ? REP_N : 1); ++rep_) { __syncthreads();
        const int* gcount = (const int*)(ws + WS_CTL) + CTL_GCOUNT;
        DownOrder S; S.T = build_table(lds + LDS_MISC, gcount, 4); S.ACT = (const char*)(ws + WS_RB); S.W = (const char*)(ws + WS_WDT); S.list = (const int*)(ws + WS_LIST); S.G = G; S.c = vcu;
        EpiDown E{(unsigned char*)(ws + WS_YP), (unsigned char*)(ws + WS_RA)};
        pg8::gemm_phase<EpiDown, DownOrder>(lds, FE, S, E);
    }
    SEAM(8);
    if (IN(10)) for (int rep_ = 0; rep_ < (REP_PH == 10 ? REP_N : 1); ++rep_) { __syncthreads();
        const int gw = vcu * NWAVES + wave, NGW = G * NWAVES;
        const unsigned char* yp = (const unsigned char*)(ws + WS_YP); const unsigned char* ys = (const unsigned char*)(ws + WS_RA);
        for (int t0 = gw; t0 < NT; t0 += 2 * NGW) {
            u32x4 raw[2][9]; f32x4 x1v[2][4];
#pragma unroll
            for (int q = 0; q < 2; ++q) { const int t = min(t0 + q * NGW, NT - 1);
#pragma unroll
                for (int r = 0; r < 8; ++r) raw[q][r] = *(const u32x4*)(yp + ((size_t)t * 8 + r) * DM + 16 * lane);
                raw[q][8] = *(const u32x4*)(ys + (size_t)t * DM + 16 * lane);
#pragma unroll
                for (int j = 0; j < 4; ++j) x1v[q][j] = *(const f32x4*)(p.out + (size_t)t * DM + 16 * lane + 4 * j); }
#pragma unroll
            for (int q = 0; q < 2; ++q) { const int t = t0 + q * NGW; if (t >= NT) break;
                const int b = t / SEQ; const float* mod = (const float*)(ws + WS_MOD) + b * 6144;
                float y[16];
#pragma unroll
                for (int i = 0; i < 16; ++i) y[i] = 0.f;
#pragma unroll
                for (int r = 0; r < 9; ++r)
#pragma unroll
                    for (int j = 0; j < 4; ++j) { const f32x2 lo = __builtin_amdgcn_cvt_pk_f32_fp8((int)raw[q][r][j], false), hi2 = __builtin_amdgcn_cvt_pk_f32_fp8((int)raw[q][r][j], true);
                        y[4 * j] += lo.x; y[4 * j + 1] += lo.y; y[4 * j + 2] += hi2.x; y[4 * j + 3] += hi2.y; }
                float s = 0.f;
#pragma unroll
                for (int i = 0; i < 16; ++i) { y[i] *= (1.f / YP_SCALE); s += y[i] * y[i]; }
                const float r_ = rsqrtf(wave_sum(s) * (1.f / DM) + EPS);
#pragma unroll
                for (int j = 0; j < 4; ++j) { const int k = 16 * lane + 4 * j;
                    const f32x4 ga = *(const f32x4*)(mod + 5120 + k), gf = *(const f32x4*)(p.g_post_ffn + k);
                    f32x4 yv; yv.x = y[4 * j]; yv.y = y[4 * j + 1]; yv.z = y[4 * j + 2]; yv.w = y[4 * j + 3];
                    *(f32x4*)(outw + (size_t)t * DM + k) = x1v[q][j] + ga * (yv * r_ * gf); } }
        }
    }
#undef IN
#undef SEAM
}

static int g_grid = 0;
static bool mega_setup() {
    if (g_grid == 0) {
        int dev = 0, cus = 0, per_cu = 0;
        if (hipGetDevice(&dev) != hipSuccess || hipDeviceGetAttribute(&cus, hipDeviceAttributeMultiprocessorCount, dev) != hipSuccess) { g_grid = -1; return false; }
        if (hipFuncSetAttribute((const void*)mega, hipFuncAttributeMaxDynamicSharedMemorySize, LDS_BYTES) != hipSuccess) { fprintf(stderr, "hipFuncSetAttribute failed\n"); g_grid = -1; return false; }
        if (hipOccupancyMaxActiveBlocksPerMultiprocessor(&per_cu, (const void*)mega, NTHR, LDS_BYTES) != hipSuccess || per_cu < 1) { fprintf(stderr, "occupancy query: %d\n", per_cu); (void)hipGetLastError(); per_cu = 1; }
        g_grid = cus;
    }
    return g_grid > 0;
}
static void launch_phases(const P& p, int lo, int hi, hipStream_t stream, int dbg = 0) {
    MArgs a{}; a.p = p; a.ph_lo = lo; a.ph_hi = hi; a.dbg = dbg;
    void* args[] = {&a};
    hipError_t e = hipLaunchCooperativeKernel((const void*)mega, dim3(g_grid), dim3(NTHR), args, LDS_BYTES, stream);
    if (e != hipSuccess) fprintf(stderr, "cooperative launch failed: %s (grid %d)\n", hipGetErrorString(e), g_grid);
}

extern "C" void kernel_launch(void* const* d_in, const int* in_sizes, int n_in, void* d_out, int out_size, void* d_ws, size_t ws_size, hipStream_t stream) {
    if (n_in != 23 || ws_size < WS_END) { fprintf(stderr, "kernel_launch: unexpected n_in %d / ws_size %zu\n", n_in, ws_size); return; }
    if (!mega_setup()) return;
    P p{};
    const float** f = (const float**)&p;
    for (int i = 0; i < 23; ++i) f[i] = (const float*)d_in[i];
    p.out = (float*)d_out; p.ws = (unsigned char*)d_ws;
    (void)hipMemsetAsync((char*)d_ws + WS_CTL, 0, 1 * MiB, stream);
    launch_phases(p, 0, 11, stream);
#if defined(XTRA_PH)
    for (int i = 0; i < XTRA_N; ++i) launch_phases(p, XTRA_PH, XTRA_PH + 1, stream, 1);
#endif
}
```

```cpp
#include <hip/hip_runtime.h>
#include <cstdint>
#include <cstdio>

constexpr int NB = 8, SEQ = 2048, DM = 1024, NT = NB * SEQ;
constexpr int DG = 512, DSB = 512, NH = 8, HD = 64;
constexpr int NE = 64, TOPK = 8, NGRP = 8, TKG = 4, FE = 256;
constexpr float EPS = 1e-6f;
constexpr float ROUTED_SCALE = 2.5f;
constexpr float LOG2E = 1.4426950408889634f;

typedef unsigned short bf16;
__host__ __device__ __forceinline__ bf16 f2bf(float f) { unsigned u = __builtin_bit_cast(unsigned, f); return (bf16)((u + 0x7fffu + ((u >> 16) & 1u)) >> 16); }
__host__ __device__ __forceinline__ float bf2f(bf16 h) { unsigned u = ((unsigned)h) << 16; return __builtin_bit_cast(float, u); }

constexpr size_t MiB = 1u << 20;
constexpr size_t WS_CTL = 0;
constexpr size_t WS_MOD = 20 * MiB;
constexpr size_t WS_WDT = 2 * MiB;
constexpr size_t WS_TOPK = 35 * MiB;
constexpr size_t WS_LIST = 36 * MiB;
constexpr size_t WS_RB = 45 * MiB;
constexpr size_t WS_VT = WS_RB + 64 * MiB;
constexpr size_t WS_KF = 239 * MiB;
constexpr size_t WS_RA = 133 * MiB;
constexpr size_t WS_WGUT = 165 * MiB;
constexpr size_t WS_H2F8 = 200 * MiB;
constexpr size_t WS_WINT = 230 * MiB;
constexpr size_t WS_WOUTT = 235 * MiB;
constexpr size_t WS_WSP = 237 * MiB;
constexpr size_t WS_WRT = 238 * MiB;
constexpr size_t WS_OSB = 239 * MiB;
constexpr size_t WS_YP = 165 * MiB;
constexpr size_t WS_END = 293 * MiB;
constexpr int LATE_GU4 = 8;
constexpr int LATE_D2 = 32, LATE_GU2 = 24, LATE_GU3 = 16;
constexpr int CW_MODCNT = 2048;
constexpr int CTL_GCOUNT = 1024;


struct P {
    const float *x, *c, *w_ada, *b_ada, *g_pre_mix, *w_in, *ln_g, *ln_b, *w_sp, *b_sp, *g_branch, *w_out, *g_post_mix, *g_pre_ffn,
        *w_router, *router_bias, *w_gate, *w_up, *w_down, *ws_gate, *ws_up, *ws_down, *g_post_ffn;
    float* out;
    unsigned char* ws;
};

__device__ __forceinline__ float block_sum(float v, float* red) {
    for (int o = 32; o > 0; o >>= 1) v += __shfl_xor(v, o);
    __syncthreads();
    if ((threadIdx.x & 63) == 0) red[threadIdx.x >> 6] = v;
    __syncthreads();
    return red[0] + red[1] + red[2] + red[3];
}
__device__ __forceinline__ float silu_f(float v) { return v / (1.f + __expf(-v)); }
__device__ __forceinline__ float gelu_tanh(float v) { const float u = 0.7978845608028654f * (v + 0.044715f * v * v * v); return 0.5f * v * (1.f + tanhf(u)); }

#define LAS __attribute__((address_space(3)))
#define GAS __attribute__((address_space(1)))
typedef short bf16x8 __attribute__((ext_vector_type(8)));
typedef float f32x4 __attribute__((ext_vector_type(4)));
typedef float f32x2 __attribute__((ext_vector_type(2)));
typedef unsigned u32x4 __attribute__((ext_vector_type(4)));
typedef unsigned u32x2 __attribute__((ext_vector_type(2)));
constexpr int NWAVES = 8, NTHR = 512;
constexpr int RING_BYTES = 131072, LDS_BYTES = 163840;
constexpr int LDS_EXTRA = 147456;
constexpr int LDS_MISC = RING_BYTES;

__device__ __forceinline__ unsigned cvt_pk_bf16(float lo, float hi) { unsigned r; asm volatile("v_cvt_pk_bf16_f32 %0, %1, %2" : "=v"(r) : "v"(lo), "v"(hi)); return r; }
template <int CTRL> __device__ __forceinline__ float dppf(float v) { return __builtin_bit_cast(float, __builtin_amdgcn_update_dpp(0, __builtin_bit_cast(int, v), CTRL, 0xf, 0xf, true)); }
__device__ __forceinline__ float rdlane(float v, int l) { return __builtin_bit_cast(float, __builtin_amdgcn_readlane(__builtin_bit_cast(int, v), l)); }
__device__ __forceinline__ float wave_sum(float v) {
    v += dppf<0xB1>(v); v += dppf<0x4E>(v); v += dppf<0x141>(v); v += dppf<0x140>(v);
    return (rdlane(v, 0) + rdlane(v, 16)) + (rdlane(v, 32) + rdlane(v, 48));
}
__device__ __forceinline__ float group8_max(float v) {
    v = __builtin_fmaxf(v, dppf<0xB1>(v)); v = __builtin_fmaxf(v, dppf<0x4E>(v)); v = __builtin_fmaxf(v, dppf<0x141>(v)); return v;
}
__device__ __forceinline__ float fast_sigmoid(float v) { return __builtin_amdgcn_rcpf(1.f + __builtin_amdgcn_exp2f(-LOG2E * v)); }
__device__ __forceinline__ float gelu_fast(float v) {
    const float u2 = v * (1.5957691216057308f + 0.07135481282748009f * v * v);
    return v * __builtin_amdgcn_rcpf(1.f + __builtin_amdgcn_exp2f(-LOG2E * u2));
}


typedef float f32x16 __attribute__((ext_vector_type(16)));
typedef short s16x4 __attribute__((ext_vector_type(4)));
typedef short s16x4_t __attribute__((ext_vector_type(4)));
typedef __bf16 bf16x2_t __attribute__((ext_vector_type(2)));
__device__ __forceinline__ unsigned cvtpk(float lo, float hi) { f32x2 v = {lo, hi}; bf16x2_t b = __builtin_convertvector(v, bf16x2_t); return __builtin_bit_cast(unsigned, b); }
__device__ __forceinline__ float bflo(unsigned u) { return __builtin_bit_cast(float, u << 16); }
__device__ __forceinline__ float bfhi(unsigned u) { return __builtin_bit_cast(float, u & 0xffff0000u); }
#define MFMA32(a, b, c) __builtin_amdgcn_mfma_f32_32x32x16_bf16((a), (b), (c), 0, 0, 0)

__device__ __forceinline__ void sb_tile(f32x16& p, float& carry, const bool diag, const int kvrel, const int hi) {
    float R[16], X[16];
#pragma unroll
    for (int r = 0; r < 16; ++r) { const float z = __builtin_amdgcn_fmed3f(p[r], -126.f, 126.f);
        const float e = __builtin_amdgcn_exp2f(z); float rr = __builtin_amdgcn_rcpf(1.f + e); float b = e * rr;
        if (diag) { const int kr = kvrel + (r & 3) + 8 * (r >> 2); if (kr >= 0) { rr = 1.f; b = 0.f; } }
        R[r] = rr; p[r] = b; }
    float T[4];
#pragma unroll
    for (int g = 0; g < 4; ++g) { X[4 * g + 3] = 1.f; X[4 * g + 2] = R[4 * g + 3]; X[4 * g + 1] = X[4 * g + 2] * R[4 * g + 2]; X[4 * g] = X[4 * g + 1] * R[4 * g + 1]; T[g] = X[4 * g] * R[4 * g]; }
    float Pp[4], S[4];
#pragma unroll
    for (int g = 0; g < 4; ++g) { const auto sw = __builtin_amdgcn_permlane32_swap(__float_as_uint(T[g]), __float_as_uint(T[g]), false, false);
        const float lo_ = __uint_as_float(sw[0]), hi_ = __uint_as_float(sw[1]); Pp[g] = hi == 0 ? hi_ : 1.f; S[g] = lo_ * hi_; }
    const float u3 = carry, u2 = u3 * S[3], u1 = u2 * S[2], u0 = u1 * S[1];
    const float off[4] = {u0 * Pp[0], u1 * Pp[1], u2 * Pp[2], u3 * Pp[3]};
    carry = u0 * S[0];
#pragma unroll
    for (int r = 0; r < 16; ++r) p[r] = p[r] * (X[r] * off[r >> 2]);
}

namespace pg8 {
constexpr int BM = 256, BK = 64, HALF = 128, HTB = HALF * BK * 2;
__host__ __device__ __forceinline__ int lds_byte(int r, int c) { const int st = (r >> 4) * 2 + (c >> 5), rr = r & 15, cc = c & 31, ob = rr * 64 + cc * 2; return st * 1024 + (ob ^ (((ob >> 9) & 1) << 5)); }
__host__ __device__ __forceinline__ void stage_rc(int b, int& R, int& C) { const int st = b / 1024, sb = b % 1024, swz = sb ^ (((sb >> 9) & 1) << 5); R = (st >> 1) * 16 + swz / 64; C = (st & 1) * 32 + (swz % 64) / 2; }
__host__ __device__ __forceinline__ int perm32(int rho) { const int n = rho >> 4, i = rho & 15; return 8 * (i >> 2) + 4 * n + (i & 3); }

struct Unit { const char* A; const char* B; const int* lst; int gather, pm, pn, nvalid, aux, tb; };

typedef int i32x8 __attribute__((ext_vector_type(8)));
typedef int i32x4_t __attribute__((ext_vector_type(4)));
template <class Epi, class Sched, bool F8 = false>
__device__ __forceinline__ void gemm_phase(LAS unsigned char* lds, const int K, const Sched& S, const Epi& E, const int f8_scales = 0) {
    const int tid = threadIdx.x, wid = __builtin_amdgcn_readfirstlane(tid >> 6), lane = tid & 63, wr = wid >> 2, wc = wid & 3, fr = lane & 15, fq = lane >> 4;
    const int nt = K / BK;
    unsigned voffB[2];
#pragma unroll
    for (int i = 0; i < 2; ++i) { int R_, C_; stage_rc(tid * 16 + i * 8192, R_, C_); const int Rb = 64 * (R_ >> 5) + 16 * ((R_ & 15) >> 2) + 4 * ((R_ >> 4) & 1) + (R_ & 3); voffB[i] = (unsigned)(Rb * K + C_) * 2u; }
    const size_t hstepB = (size_t)8 * K * 2;
    const size_t kstep = (size_t)(BK * 2);
    const unsigned ldsw = (unsigned)wid * 1024u;
    const int aoff = F8 ? lds_byte(wr * 64 + fr, fq * 16) + 16 * (fq & 1) : lds_byte(wr * 64 + fr, fq * 8), boff = F8 ? lds_byte(wc * 32 + fr, fq * 16) + 16 * (fq & 1) : lds_byte(wc * 32 + fr, fq * 8);
    const int aoff2 = aoff + 16 - 32 * (fq & 1), boff2 = boff + 16 - 32 * (fq & 1);
    int scl = f8_scales; asm volatile("" : "+v"(scl));
#define PG8_SA(b, h) (((b) * 2 + (h)) * HTB)
#define PG8_SB(b, h) ((4 + (b) * 2 + (h)) * HTB)
#define PG8_STAGE2(bufoff, gbase, v0, v1) do { const char* gb_ = (const char*)(gbase); asm volatile("" : "+s"(gb_), "+v"(v0), "+v"(v1)); \
        __builtin_amdgcn_global_load_lds((const unsigned*)(gb_ + (v0)), (LAS unsigned*)(lds + (bufoff) + ldsw), 16, 0, 0); \
        __builtin_amdgcn_global_load_lds((const unsigned*)(gb_ + (v1)), (LAS unsigned*)(lds + (bufoff) + ldsw + 8192), 16, 0, 0); } while (0)
#define PG8_STAGEB(b, h, gbase) PG8_STAGE2(PG8_SB(b, h), (gbase) + (h) * hstepB, voffB[0], voffB[1])
#define PG8_LDA(dst, b, h) do { if constexpr (F8) { _Pragma("unroll") for (int m = 0; m < 4; ++m) { const i32x4_t lo_ = *(const LAS i32x4_t*)(lds + PG8_SA(b, h) + aoff + m * 2048), hi_ = *(const LAS i32x4_t*)(lds + PG8_SA(b, h) + aoff2 + m * 2048); dst##8[m] = __builtin_shufflevector(lo_, hi_, 0, 1, 2, 3, 4, 5, 6, 7); } } else _Pragma("unroll") for (int m = 0; m < 4; ++m) _Pragma("unroll") for (int k = 0; k < 2; ++k) dst[m][k] = *(const LAS bf16x8*)(lds + PG8_SA(b, h) + aoff + m * 2048 + k * 1024); } while (0)
#define PG8_LDB(dst, b, h) do { if constexpr (F8) { _Pragma("unroll") for (int n = 0; n < 2; ++n) { const i32x4_t lo_ = *(const LAS i32x4_t*)(lds + PG8_SB(b, h) + boff + n * 2048), hi_ = *(const LAS i32x4_t*)(lds + PG8_SB(b, h) + boff2 + n * 2048); dst##8[n] = __builtin_shufflevector(lo_, hi_, 0, 1, 2, 3, 4, 5, 6, 7); } } else _Pragma("unroll") for (int n = 0; n < 2; ++n) _Pragma("unroll") for (int k = 0; k < 2; ++k) dst[n][k] = *(const LAS bf16x8*)(lds + PG8_SB(b, h) + boff + n * 2048 + k * 1024); } while (0)
#define PG8_MMA(ai, bj, At, Bt) do { __builtin_amdgcn_s_setprio(1); if constexpr (F8) { _Pragma("unroll") for (int m = 0; m < 4; ++m) _Pragma("unroll") for (int n = 0; n < 2; ++n) asm volatile("v_mfma_scale_f32_16x16x128_f8f6f4 %0, %1, %2, %0, %3, %3 op_sel:[1,0,0] op_sel_hi:[0,0,0]" : "+v"(acc[ai][bj][m][n]) : "v"(Bt##8[n]), "v"(At##8[m]), "v"(scl)); } else _Pragma("unroll") for (int m = 0; m < 4; ++m) _Pragma("unroll") for (int n = 0; n < 2; ++n) _Pragma("unroll") for (int k = 0; k < 2; ++k) \
        acc[ai][bj][m][n] = __builtin_amdgcn_mfma_f32_16x16x32_bf16(Bt[n][k], At[m][k], acc[ai][bj][m][n], 0, 0, 0); __builtin_amdgcn_s_setprio(0); } while (0)
#define PG8_WAIT_V(n) asm volatile("s_waitcnt vmcnt(" #n ")" ::: "memory")
#define PG8_WAIT_L(n) asm volatile("s_waitcnt lgkmcnt(" #n ")" ::: "memory")
#define PG8_BAR __builtin_amdgcn_s_barrier()
#define PG8_SCHED __builtin_amdgcn_sched_barrier(0)
#define PG8_TBL(i) (LDS_MISC + 2048 + ((i) % 3) * 2048)
#define PG8_IDXDMA(u, tboff) do { if ((u).lst) { const int e_ = min(32 * wid + (lane >> 1), (u).nvalid - 1); \
        __builtin_amdgcn_global_load_lds((const unsigned*)((u).lst + e_ * 2 + (lane & 1)), (LAS unsigned*)(lds + (tboff) + 256 * wid), 4, 0, 0); } } while (0)
#define PG8_AOFFS(u, o00, o01, o10, o11) do { int Rr[2], Cc[2]; stage_rc((int)threadIdx.x * 16, Rr[0], Cc[0]); stage_rc((int)threadIdx.x * 16 + 8192, Rr[1], Cc[1]); \
        int r00 = Rr[0], r01 = Rr[1], r10 = Rr[0] + HALF, r11 = Rr[1] + HALF; \
        if ((u).gather) { const LAS int* tb_ = (const LAS int*)(lds + (u).tb); r00 = tb_[2 * r00] >> 3; r01 = tb_[2 * r01] >> 3; r10 = tb_[2 * r10] >> 3; r11 = tb_[2 * r11] >> 3; } \
        o00 = (unsigned)(r00 * K + Cc[0]) * 2u; o01 = (unsigned)(r01 * K + Cc[1]) * 2u; o10 = (unsigned)(r10 * K + Cc[0]) * 2u; o11 = (unsigned)(r11 * K + Cc[1]) * 2u; } while (0)
    Unit cur, nxt; int ui = 0;
    if (!S.next(0, cur)) return;
    f32x4 acc[2][2][4][2];
#pragma unroll
    for (int a = 0; a < 2; ++a)
#pragma unroll
        for (int b = 0; b < 2; ++b)
#pragma unroll
            for (int m = 0; m < 4; ++m)
#pragma unroll
                for (int n = 0; n < 2; ++n) acc[a][b][m][n] = (f32x4){0.f, 0.f, 0.f, 0.f};
    bf16x8 At[4][2], B0[2][2], B1[2][2]; i32x8 At8[4], B08[2], B18[2];
    unsigned c00, c01, c10, c11;
    cur.tb = PG8_TBL(0);
    const char* cA = cur.A; const char* cB = cur.B;
    if (cur.lst) PG8_IDXDMA(cur, cur.tb);
    PG8_STAGEB(0, 0, cB); PG8_STAGEB(0, 1, cB);
    if (cur.lst && cur.gather) PG8_WAIT_V(0);
    __syncthreads();
    PG8_AOFFS(cur, c00, c01, c10, c11);
    PG8_STAGE2(PG8_SA(0, 0), cA, c00, c01); PG8_STAGE2(PG8_SA(0, 1), cA, c10, c11);
    if (wr == 1) PG8_BAR;
    PG8_WAIT_V(2); PG8_BAR;
    PG8_STAGEB(1, 0, cB + kstep); PG8_STAGE2(PG8_SA(1, 0), cA + kstep, c00, c01); PG8_STAGEB(1, 1, cB + kstep);
    PG8_WAIT_V(6); PG8_BAR;
    for (;;) {
        const bool has_next = S.next(ui + 1, nxt);
        const char* nA; const char* nB;
        if (has_next) { nA = nxt.A; nB = nxt.B; nxt.tb = PG8_TBL(ui + 1); PG8_IDXDMA(nxt, nxt.tb); } else { nA = cA; nB = cB; }
#pragma unroll 1
        for (int t = 0; t < nt; t += 2) {
            const bool last = (t == nt - 2);
            const char* a1 = cA + (size_t)(t + 1) * kstep;
            const char* a2 = last ? nA : cA + (size_t)(t + 2) * kstep; const char* b2 = last ? nB : cB + (size_t)(t + 2) * kstep;
            const char* a3 = a2 + kstep; const char* b3 = b2 + kstep;
            PG8_LDB(B0, 0, 0); PG8_LDB(B1, 0, 1); PG8_SCHED; PG8_LDA(At, 0, 0); PG8_STAGE2(PG8_SA(1, 1), a1, c10, c11);
            PG8_WAIT_V(8); PG8_WAIT_L(0); PG8_BAR; PG8_MMA(0, 0, At, B0); PG8_MMA(0, 1, At, B1); PG8_BAR; PG8_SCHED;
            if (last && has_next) { PG8_AOFFS(nxt, c00, c01, c10, c11); PG8_SCHED; }
            PG8_LDA(At, 0, 1); PG8_STAGEB(0, 0, b2); PG8_STAGEB(0, 1, b2); PG8_STAGE2(PG8_SA(0, 0), a2, c00, c01);
            PG8_WAIT_V(8); PG8_WAIT_L(0); PG8_BAR; PG8_MMA(1, 0, At, B0); PG8_MMA(1, 1, At, B1); PG8_BAR; PG8_SCHED;
            PG8_LDB(B0, 1, 0); PG8_LDB(B1, 1, 1); PG8_SCHED; PG8_LDA(At, 1, 0); PG8_STAGE2(PG8_SA(0, 1), a2, c10, c11);
            PG8_WAIT_V(8); PG8_WAIT_L(0); PG8_BAR; PG8_MMA(0, 0, At, B0); PG8_MMA(0, 1, At, B1); PG8_BAR; PG8_SCHED;
            PG8_LDA(At, 1, 1); PG8_STAGEB(1, 0, b3); PG8_STAGEB(1, 1, b3); PG8_STAGE2(PG8_SA(1, 0), a3, c00, c01);
            PG8_WAIT_V(8); PG8_WAIT_L(0); PG8_BAR; PG8_MMA(1, 0, At, B0); PG8_MMA(1, 1, At, B1); PG8_BAR; PG8_SCHED;
        }
        if (wr == 0) PG8_BAR;
        if constexpr (F8) { asm volatile("s_nop 15\n\ts_nop 15" ::: "memory"); PG8_SCHED; }
        E(acc, cur, wr, wc, fr, fq, lds);
        if (!has_next) break;
#pragma unroll
        for (int a = 0; a < 2; ++a)
#pragma unroll
            for (int b = 0; b < 2; ++b)
#pragma unroll
                for (int m = 0; m < 4; ++m)
#pragma unroll
                    for (int n = 0; n < 2; ++n) acc[a][b][m][n] = (f32x4){0.f, 0.f, 0.f, 0.f};
        cur = nxt; cA = nA; cB = nB; ++ui;
        if (wr == 1) PG8_BAR;
    }
    PG8_WAIT_V(0);
    PG8_BAR;
#undef PG8_SA
#undef PG8_SB
#undef PG8_STAGE2
#undef PG8_STAGEB
#undef PG8_LDA
#undef PG8_LDB
#undef PG8_MMA
#undef PG8_WAIT_V
#undef PG8_WAIT_L
#undef PG8_BAR
#undef PG8_SCHED
#undef PG8_AOFFS
#undef PG8_IDXDMA
#undef PG8_TBL
}
}

struct DenseOrder {
    const char* A; const char* B; int K, nM, nN, nwg, G, c, tpn;
    __device__ void init(const void* A_, const void* B_, int M, int N, int K_, int G_, int c_, int tpn_ = 1 << 30) { A = (const char*)A_; B = (const char*)B_; K = K_; nM = M / 256; nN = N / 256; nwg = nM * nN; G = G_; c = c_; tpn = tpn_; }
    __device__ bool next(int i, pg8::Unit& u) const {
        const long L = (long)i * G + c; if (L >= nwg) return false;
        int wgid = (int)L; { const int q = nwg / 8, r = nwg % 8, xcd = wgid % 8, off = wgid / 8; wgid = (xcd < r ? xcd * (q + 1) : r * (q + 1) + (xcd - r) * q) + off; }
        const int nig = 8 * nN, gid = wgid / nig, fm = gid * 8, gsz = (nM - fm) < 8 ? (nM - fm) : 8;
        u.pm = fm + ((wgid % nig) % gsz); u.pn = (wgid % nig) / gsz;
        u.A = A + (size_t)u.pm * 256 * K * 2; u.B = B + (size_t)u.pn * 256 * K * 2;
        if (u.pn >= tpn) { const char* t_ = u.A; u.A = u.B; u.B = t_; } u.lst = nullptr; u.gather = 0; u.nvalid = 256; u.aux = 0; u.tb = 0; return true;
    }
};

__device__ __forceinline__ size_t kf_off(int bh, int s, int c  ) { return ((((size_t)bh * 64 + (s >> 5)) * 4 + (c >> 4)) * 64 + ((c >> 3) & 1) * 32 + (s & 31)) * 8; }
__device__ __forceinline__ size_t vf_off(int bh, int s, int d) { const int kr = s & 31; return (((((size_t)bh * 64 + (s >> 5)) * 2 + (d >> 5)) * 2 + (kr >> 4)) * 64 + ((kr >> 2) & 1) * 32 + (d & 31)) * 8 + ((kr >> 3) & 1) * 4 + (kr & 3); }
struct EpiInProj {
    static constexpr bool PERM = true;
    bf16* proj; bf16* kf; bf16* vf;
    __device__ __forceinline__ void operator()(const f32x4 (&acc)[2][2][4][2], const pg8::Unit& u, int wr, int wc, int fr, int fq, LAS unsigned char*) const {
        const int row0 = u.pm * 256 + wr * 64 + fr, col0 = u.pn * 256 + wc * 64 + 16 * fq;
        if (u.pn < 6) {
#pragma unroll
            for (int ai = 0; ai < 2; ++ai)
#pragma unroll
                for (int m = 0; m < 4; ++m) { bf16* rowp = proj + (size_t)(row0 + ai * 128 + m * 16) * 2048 + col0;
#pragma unroll
                    for (int bj = 0; bj < 2; ++bj) { f32x4 v0 = acc[ai][bj][m][0], v1 = acc[ai][bj][m][1];
                        if (u.pn < 4) {
#pragma unroll
                            for (int j = 0; j < 4; ++j) { v0[j] = gelu_fast(v0[j]); v1[j] = gelu_fast(v1[j]); }
                        } else { v0 = v0 * (0.125f * LOG2E); v1 = v1 * (0.125f * LOG2E); }
                        u32x4 w; w.x = cvt_pk_bf16(v0[0], v0[1]); w.y = cvt_pk_bf16(v0[2], v0[3]); w.z = cvt_pk_bf16(v1[0], v1[1]); w.w = cvt_pk_bf16(v1[2], v1[3]);
                        *(u32x4*)(rowp + bj * 8) = w; } }
        } else if (u.pn < 8) {
#pragma unroll
            for (int ai = 0; ai < 2; ++ai)
#pragma unroll
                for (int m = 0; m < 4; ++m) { const int r = row0 + ai * 128 + m * 16, b = r / SEQ, sq = r % SEQ;
#pragma unroll
                    for (int bj = 0; bj < 2; ++bj) { const int hd = col0 + bj * 8 - 1536; const f32x4 v0 = acc[ai][bj][m][0], v1 = acc[ai][bj][m][1];
                        u32x4 w; w.x = cvt_pk_bf16(v0[0], v0[1]); w.y = cvt_pk_bf16(v0[2], v0[3]); w.z = cvt_pk_bf16(v1[0], v1[1]); w.w = cvt_pk_bf16(v1[2], v1[3]);
                        *(u32x4*)(kf + kf_off(b * NH + (hd >> 6), sq, hd & 63)) = w; } }
        } else {
            const int s0 = u.pm * 256 + wc * 64 + 16 * fq, b = s0 / SEQ, sq = s0 % SEQ;
#pragma unroll
            for (int ai = 0; ai < 2; ++ai)
#pragma unroll
                for (int m = 0; m < 4; ++m) { const int hd = (u.pn - 8) * 256 + ai * 128 + wr * 64 + m * 16 + fr;
                    bf16* dst = vf + vf_off(b * NH + (hd >> 6), sq, hd & 63);
#pragma unroll
                    for (int n = 0; n < 2; ++n) { const f32x4 v0 = acc[ai][0][m][n], v1 = acc[ai][1][m][n];
                        u32x4 w; w.x = cvt_pk_bf16(v0[0], v0[1]); w.y = cvt_pk_bf16(v0[2], v0[3]); w.z = cvt_pk_bf16(v1[0], v1[1]); w.w = cvt_pk_bf16(v1[2], v1[3]);
                        *(u32x4*)(dst + n * 256) = w; } }
        }
    }
};

struct EpiY {
    static constexpr bool PERM = true;
    bf16* C;
    __device__ __forceinline__ void operator()(const f32x4 (&acc)[2][2][4][2], const pg8::Unit& u, int wr, int wc, int fr, int fq, LAS unsigned char*) const {
        const int row0 = u.pm * 256 + wr * 64 + fr, col0 = u.pn * 256 + wc * 64 + 16 * fq;
#pragma unroll
        for (int ai = 0; ai < 2; ++ai)
#pragma unroll
            for (int m = 0; m < 4; ++m) { bf16* rowp = C + (size_t)(row0 + ai * 128 + m * 16) * DM + col0;
#pragma unroll
                for (int bj = 0; bj < 2; ++bj) { const f32x4 v0 = acc[ai][bj][m][0], v1 = acc[ai][bj][m][1];
                    u32x4 w; w.x = cvt_pk_bf16(v0[0], v0[1]); w.y = cvt_pk_bf16(v0[2], v0[3]); w.z = cvt_pk_bf16(v1[0], v1[1]); w.w = cvt_pk_bf16(v1[2], v1[3]);
                    *(u32x4*)(rowp + bj * 8) = w; } }
    }
};
__device__ __forceinline__ int uni(int v) { return __builtin_amdgcn_readfirstlane(v); }
template <class T> __device__ __forceinline__ T* unip(T* p_) { const unsigned long long v = (unsigned long long)p_; const unsigned lo = __builtin_amdgcn_readfirstlane((unsigned)v), hi = __builtin_amdgcn_readfirstlane((unsigned)(v >> 32)); return (T*)(((unsigned long long)hi << 32) | lo); }

typedef int i32x4q __attribute__((ext_vector_type(4)));
struct GTable { LAS const int* pre; LAS const int* lst; LAS const int* cnt; LAS const int* abase; LAS const int* mine; int nent; };
__device__ __forceinline__ bool gt_find(const GTable& T, int L, int& l, int& r) {
    if (L >= T.pre[T.nent]) return false;
    int lo = 0, hi = T.nent;
    while (hi - lo > 1) { const int mid = (lo + hi) >> 1; if (T.pre[mid] <= L) lo = mid; else hi = mid; }
    l = T.lst[lo]; r = L - T.pre[lo]; return true;
}
struct GateUpOrder {
    GTable T; const char* H2; const char* W; const int* list; int G, c;
    __device__ __forceinline__ bool next(int i, pg8::Unit& u) const {
        if (i >= 32) return false;
        const i32x4q m4 = *(const LAS i32x4q*)(T.mine + 4 * i); const int e = uni(m4.x), r = uni(m4.y), ab_ = uni(m4.z), cn_ = uni(m4.w); if (e < 0) return false;
        const int tile = r >> 1, pn = r & 1;
        u.pm = e; u.pn = pn; u.aux = ab_ + tile * 256; u.tb = 0;
        if (e < NE) { u.A = H2; u.lst = list + ((size_t)e * NT + tile * 256) * 2; u.gather = 1; u.nvalid = min(256, cn_ - tile * 256); }
        else { u.A = H2 + (size_t)tile * 256 * DM; u.lst = nullptr; u.gather = 0; u.nvalid = 256; }
        u.B = W + ((size_t)e * 512 + pn * 256) * DM; return true;
    }
};
struct DownOrder {
    GTable T; const char* ACT; const char* W; const int* list; int G, c;
    __device__ __forceinline__ bool next(int i, pg8::Unit& u) const {
        if (i >= 32) return false;
        const i32x4q m4 = *(const LAS i32x4q*)(T.mine + 4 * i); const int e = uni(m4.x), r = uni(m4.y), ab_ = uni(m4.z), cn_ = uni(m4.w); if (e < 0) return false;
        const int tile = r >> 2, pn = r & 3;
        u.pm = e; u.pn = pn; u.aux = tile * 256; u.gather = 0; u.tb = 0;
        u.A = ACT + ((size_t)ab_ + tile * 256) * FE;
        if (e < NE) { u.lst = list + ((size_t)e * NT + tile * 256) * 2; u.nvalid = min(256, cn_ - tile * 256); } else { u.lst = nullptr; u.nvalid = 256; }
        u.B = W + ((size_t)e * DM + pn * 256) * FE; return true;
    }
};
constexpr float ACT8_SCALE = 16.f;
struct EpiGateUp {
    static constexpr bool PERM = true;
    unsigned char* act;
    __device__ __forceinline__ void operator()(const f32x4 (&acc)[2][2][4][2], const pg8::Unit& u, int wr, int wc, int fr, int fq, LAS unsigned char* lds) const {
        const int f0 = u.pn * 128 + wc * 32 + 8 * fq;
        const LAS float* tb = (const LAS float*)(lds + u.tb);
        float wrow[2][4];
#pragma unroll
        for (int ai = 0; ai < 2; ++ai)
#pragma unroll
            for (int m = 0; m < 4; ++m) wrow[ai][m] = tb[2 * (ai * 128 + wr * 64 + m * 16 + fr) + 1];
        const bool routed = u.lst != nullptr;
#pragma unroll
        for (int ai = 0; ai < 2; ++ai)
#pragma unroll
            for (int m = 0; m < 4; ++m) { const int tr = ai * 128 + wr * 64 + m * 16 + fr; const float w = (routed ? wrow[ai][m] : 1.f) * ACT8_SCALE;
                float a8[8];
#pragma unroll
                for (int bj = 0; bj < 2; ++bj) { const f32x4 g = acc[ai][bj][m][0], up = acc[ai][bj][m][1];
#pragma unroll
                    for (int j = 0; j < 4; ++j) a8[4 * bj + j] = __builtin_amdgcn_fmed3f(g[j] * fast_sigmoid(g[j]) * up[j] * w, -448.f, 448.f); }
                int o0 = __builtin_amdgcn_cvt_pk_fp8_f32(a8[0], a8[1], 0, false); o0 = __builtin_amdgcn_cvt_pk_fp8_f32(a8[2], a8[3], o0, true);
                int o1 = __builtin_amdgcn_cvt_pk_fp8_f32(a8[4], a8[5], 0, false); o1 = __builtin_amdgcn_cvt_pk_fp8_f32(a8[6], a8[7], o1, true);
                u32x2 o; o.x = (unsigned)o0; o.y = (unsigned)o1;
                *(u32x2*)(act + (size_t)(u.aux + tr) * FE + f0) = o; }
    }
};
constexpr float YP_SCALE = 16.f;
struct EpiDown {
    static constexpr bool PERM = true;
    unsigned char* yp; unsigned char* ys;
    __device__ __forceinline__ void operator()(const f32x4 (&acc)[2][2][4][2], const pg8::Unit& u, int wr, int wc, int fr, int fq, LAS unsigned char* lds) const {
        const int col0 = u.pn * 256 + wc * 64 + 16 * fq;
        const LAS int* tb = (const LAS int*)(lds + u.tb);
        int tk[2][4];
#pragma unroll
        for (int ai = 0; ai < 2; ++ai)
#pragma unroll
            for (int m = 0; m < 4; ++m) tk[ai][m] = tb[2 * (ai * 128 + wr * 64 + m * 16 + fr)];
        const int routed = u.lst ? -1 : 0; unsigned char* const obase = u.lst ? yp : ys;
#pragma unroll
        for (int ai = 0; ai < 2; ++ai)
#pragma unroll
            for (int m = 0; m < 4; ++m) { const int tr = ai * 128 + wr * 64 + m * 16 + fr;
                const int rowi = (tk[ai][m] & routed) | ((u.aux + tr) & ~routed);
                unsigned char* rowp = obase + (size_t)(unsigned)rowi * DM + col0;
                u32x4 o;
#pragma unroll
                for (int bj = 0; bj < 2; ++bj) { f32x4 v0 = acc[ai][bj][m][0], v1 = acc[ai][bj][m][1];
#pragma unroll
                    for (int j = 0; j < 4; ++j) { v0[j] = __builtin_amdgcn_fmed3f(v0[j], -448.f, 448.f); v1[j] = __builtin_amdgcn_fmed3f(v1[j], -448.f, 448.f); }
                    int w0 = __builtin_amdgcn_cvt_pk_fp8_f32(v0[0], v0[1], 0, false); w0 = __builtin_amdgcn_cvt_pk_fp8_f32(v0[2], v0[3], w0, true);
                    int w1 = __builtin_amdgcn_cvt_pk_fp8_f32(v1[0], v1[1], 0, false); w1 = __builtin_amdgcn_cvt_pk_fp8_f32(v1[2], v1[3], w1, true);
                    o[2 * bj] = (unsigned)w0; o[2 * bj + 1] = (unsigned)w1; }
                if (tr < u.nvalid) *(u32x4*)rowp = o; }
    }
};
__device__ __forceinline__ GTable build_table(LAS unsigned char* misc, const int* gcount, int upt, int c, int G) {
    LAS int* pre = (LAS int*)misc; LAS int* lst = pre + 72; LAS int* cnt = lst + 72; LAS int* abase = cnt + 72; LAS int* nent = abase + 72;
    __syncthreads();
    if (threadIdx.x < NE) {
        const int lane_ = threadIdx.x, c_ = gcount[lane_], ntile = (c_ + 255) >> 8, has = ntile > 0 ? 1 : 0;
        int st = ntile, sh = has;
#pragma unroll
        for (int o = 1; o < 64; o <<= 1) { const int a_ = __shfl_up(st, o), b_ = __shfl_up(sh, o); if (lane_ >= o) { st += a_; sh += b_; } }
        cnt[lane_] = c_; abase[lane_] = (st - ntile) * 256;
        if (has) { pre[sh - 1] = (st - ntile) * upt; lst[sh - 1] = lane_; }
        if (lane_ == NE - 1) {
            cnt[NE] = NT; abase[NE] = st * 256; pre[sh] = st * upt; lst[sh] = NE; pre[sh + 1] = (st + NT / 256) * upt; nent[0] = sh + 1; }
    }
    __syncthreads();
    GTable T; T.pre = pre; T.lst = lst; T.cnt = cnt; T.abase = abase; T.nent = uni(nent[0]);
    LAS int* mine = nent + 4; T.mine = mine;
    if (threadIdx.x < 32) { int l = -1, r = -1; if (!gt_find(T, (int)threadIdx.x * G + c, l, r)) { l = -1; r = -1; }
        mine[4 * threadIdx.x] = l; mine[4 * threadIdx.x + 1] = r; mine[4 * threadIdx.x + 2] = l >= 0 ? abase[l] : 0; mine[4 * threadIdx.x + 3] = l >= 0 ? cnt[l] : 0; }
    __syncthreads();
    return T;
}


typedef GAS unsigned gu32;
#define XB_TMO      128
#define XB_XCNT(j)  (256  + 64 * (j))
#define XB_XSUB(j)  (1280 + 64 * (j))
#define XB_XGEN(j)  (2304 + 64 * (j))
#define XB_TOP      3328
#define XB_TOPGEN   3392
#define XCD_BAR_WORDS 3456
#define XB_SPIN_CAP (1u << 18)
constexpr int CW_BAR = 4096;
__device__ __forceinline__ unsigned xb_ld(unsigned* p)              { return __hip_atomic_load(p, __ATOMIC_RELAXED, __HIP_MEMORY_SCOPE_AGENT); }
__device__ __forceinline__ unsigned xb_add(unsigned* p, unsigned v) { return __hip_atomic_fetch_add(p, v, __ATOMIC_RELAXED, __HIP_MEMORY_SCOPE_AGENT); }
__device__ __forceinline__ unsigned xb_xcc_id() { return (unsigned)__builtin_amdgcn_s_getreg((3 << 11) | 20) & 0xFu; }
#define XB_SPIN(cond, bar) do { unsigned _sp = 0; while (cond) { __builtin_amdgcn_s_sleep(1); \
    if ((++_sp & 255u) == 0u) { if (xb_ld(&(bar)[XB_TMO])) break; if (_sp > XB_SPIN_CAP) { atomicAdd(&(bar)[XB_TMO], 1u); break; } } } } while (0)
struct XcdBarrier { unsigned* bar; unsigned x; volatile LAS unsigned* st; };
__device__ __forceinline__ XcdBarrier xcd_barrier_post(unsigned* bar, volatile LAS unsigned* st) {
    XcdBarrier b; b.bar = bar; b.x = xb_xcc_id(); b.st = st;
    if (threadIdx.x == 0) (void)xb_add(&bar[XB_XCNT(b.x)], 1u);
    return b;
}
__device__ __forceinline__ void xcd_barrier_complete(unsigned* bar, unsigned x, unsigned& nloc, unsigned& nx) {
    const unsigned G = gridDim.x * gridDim.y * gridDim.z;
    unsigned sum, cnt, mine, sp = 0u;
    for (;;) {
        sum = 0u; cnt = 0u; mine = 0u;
#pragma unroll
        for (unsigned j = 0; j < 16; ++j) { const unsigned c = xb_ld(&bar[XB_XCNT(j)]); sum += c; cnt += (c > 0u) ? 1u : 0u; mine = (j == x) ? c : mine; }
        if (sum == G) break;
        __builtin_amdgcn_s_sleep(1);
        if ((++sp & 255u) == 0u) { if (xb_ld(&bar[XB_TMO])) break; if (sp > XB_SPIN_CAP) { atomicAdd(&bar[XB_TMO], 1u); break; } }
    }
    nloc = mine > 0u ? mine : 1u; nx = cnt > 0u ? cnt : 1u;
}
__device__ __forceinline__ void xcd_barrier(const XcdBarrier& b) {
    asm volatile("s_waitcnt vmcnt(0)" ::: "memory");
    __syncthreads();
    if (threadIdx.x == 0) {
        unsigned* bar = b.bar;
        __builtin_amdgcn_s_waitcnt(0);
        unsigned nloc = b.st[0], nx = b.st[1];
        if (nloc == 0u) { xcd_barrier_complete(bar, b.x, nloc, nx); b.st[0] = nloc; b.st[1] = nx; }
        const unsigned old = xb_add(&bar[XB_XSUB(b.x)], 1u);
        const unsigned gen = old / nloc;
        if (old + 1u == (gen + 1u) * nloc) {
            __builtin_amdgcn_fence(__ATOMIC_RELEASE, "agent");
            asm volatile("s_waitcnt vmcnt(0)" ::: "memory");
            const unsigned og = xb_add(&bar[XB_TOP], 1u);
            const unsigned tg = og / nx;
            if (og + 1u == (tg + 1u) * nx) xb_add(&bar[XB_TOPGEN], 1u);
            else XB_SPIN(xb_ld(&bar[XB_TOPGEN]) == tg, bar);
            __builtin_amdgcn_fence(__ATOMIC_ACQUIRE, "agent");
            xb_add(&bar[XB_XGEN(b.x)], 1u);
            asm volatile("s_waitcnt vmcnt(0)" ::: "memory");
        } else {
            XB_SPIN(xb_ld(&bar[XB_XGEN(b.x)]) == gen, bar);
            __builtin_amdgcn_fence(__ATOMIC_ACQUIRE, "agent");
            asm volatile("s_waitcnt vmcnt(0)" ::: "memory");
        }
    }
    __syncthreads();
}

#ifndef REP_PH
#define REP_PH -1
#endif
#ifndef REP_N
#define REP_N 1
#endif
constexpr float W8_SCALE = 32.f, WD8_SCALE = 16.f;
struct TItem { const float* W; bf16* WT; int K, N, mode, r, nt; float f8; };
__device__ __forceinline__ void ti_load(const TItem& t, float (&v)[32], int lane) {
    const int nblk = t.N / 32, k0 = 64 * (t.r / nblk), n0 = 32 * (t.r % nblk);
#pragma unroll
    for (int j = 0; j < 8; ++j) { const f32x4 q = __builtin_nontemporal_load((const f32x4*)(t.W + (size_t)(k0 + 8 * j + (lane >> 3)) * t.N + n0 + 4 * (lane & 7)));
        v[4 * j] = q.x; v[4 * j + 1] = q.y; v[4 * j + 2] = q.z; v[4 * j + 3] = q.w; }
}
__device__ __forceinline__ void ti_store(const TItem& t, const float (&v)[32], LAS float* scr, int lane) {
    const int nblk = t.N / 32, k0 = 64 * (t.r / nblk), n0 = 32 * (t.r % nblk);
#pragma unroll
    for (int i = 0; i < 32; ++i) scr[(8 * (i >> 2) + (lane >> 3)) * 33 + 4 * (lane & 7) + (i & 3)] = v[i];
    asm volatile("s_waitcnt lgkmcnt(0)" ::: "memory");
    if (t.f8 != 0.f) {
        const int c4 = lane & 3;
#pragma unroll
        for (int j = 0; j < 2; ++j) { const int n = (lane >> 2) + 16 * j; const LAS float* sp = scr + (16 * c4) * 33 + n; unsigned w[4];
#pragma unroll
            for (int q = 0; q < 4; ++q) { float f[4];
#pragma unroll
                for (int i = 0; i < 4; ++i) f[i] = __builtin_amdgcn_fmed3f(sp[(4 * q + i) * 33] * t.f8, -448.f, 448.f);
                int pk = __builtin_amdgcn_cvt_pk_fp8_f32(f[0], f[1], 0, false); pk = __builtin_amdgcn_cvt_pk_fp8_f32(f[2], f[3], pk, true); w[q] = (unsigned)pk; }
            const int nn = n0 + n; const int row = (t.mode == 0) ? nn : (8 * (nn >> 2) + (nn & 3) + 4 * (t.mode - 1));
            u32x4 o; o.x = w[0]; o.y = w[1]; o.z = w[2]; o.w = w[3];
            u32x4* dst = (u32x4*)((unsigned char*)t.WT + (size_t)row * t.K + k0 + 16 * c4);
            if (t.nt) __builtin_nontemporal_store(o, dst); else *dst = o; }
        asm volatile("s_waitcnt lgkmcnt(0)" ::: "memory");
        return; }
    const int c = lane & 7;
#pragma unroll
    for (int j = 0; j < 4; ++j) { const int n = (lane >> 3) + 8 * j; const LAS float* sp = scr + (8 * c) * 33 + n;
        u32x4 o; o.x = cvt_pk_bf16(sp[0 * 33], sp[1 * 33]); o.y = cvt_pk_bf16(sp[2 * 33], sp[3 * 33]); o.z = cvt_pk_bf16(sp[4 * 33], sp[5 * 33]); o.w = cvt_pk_bf16(sp[6 * 33], sp[7 * 33]);
        const int nn = n0 + n; const int row = (t.mode == 0) ? nn : (8 * (nn >> 2) + (nn & 3) + 4 * (t.mode - 1));
        u32x4* dst = (u32x4*)(t.WT + (size_t)row * t.K + k0 + 8 * c);
        if (t.nt) __builtin_nontemporal_store(o, dst); else *dst = o; }
    asm volatile("s_waitcnt lgkmcnt(0)" ::: "memory");
}
constexpr int TI_IN = 16 * 80, TI_OUT = 16 * 32, TI_G = 16 * 8, TI_D = 4 * 32, TI_NGU0 = 65 - LATE_GU2 - LATE_GU3 - LATE_GU4;
constexpr int TI_N0 = TI_IN + TI_OUT + TI_NGU0 * 2 * TI_G + TI_D;
__device__ __forceinline__ TItem ti_decode0(const P& p, unsigned char* ws, int it) {
    TItem t; int r = it;
    if (r < TI_IN) { t.W = p.w_in; t.WT = (bf16*)(ws + WS_WINT); t.K = DM; t.N = 2560; t.mode = 0; t.r = r; t.nt = 0; t.f8 = 0.f; return t; } r -= TI_IN;
    if (r < TI_OUT) { t.W = p.w_out; t.WT = (bf16*)(ws + WS_WOUTT); t.K = DM; t.N = DM; t.mode = 0; t.r = r; t.nt = 0; t.f8 = 0.f; return t; } r -= TI_OUT;
    if (r < TI_NGU0 * 2 * TI_G) { const int e = LATE_GU2 + LATE_GU3 + LATE_GU4 + r / (2 * TI_G); r %= (2 * TI_G); const int up = r >= TI_G; if (up) r -= TI_G;
        t.W = e < 64 ? (up ? p.w_up : p.w_gate) + (size_t)e * DM * FE : (up ? p.ws_up : p.ws_gate); t.WT = (bf16*)(ws + WS_WGUT + (size_t)e * 512 * DM); t.K = DM; t.N = FE; t.mode = 1 + up; t.r = r; t.nt = 1; t.f8 = W8_SCALE; return t; }
    r -= TI_NGU0 * 2 * TI_G;
    t.W = p.ws_down; t.WT = (bf16*)(ws + WS_WDT + (size_t)64 * DM * FE); t.K = FE; t.N = DM; t.mode = 0; t.r = r; t.nt = 1; t.f8 = WD8_SCALE; return t;
}
__device__ __forceinline__ TItem ti_decode_late(const P& p, unsigned char* ws, int which, int i) {
    TItem t; t.nt = 1;
    if (which >= 3) { const int e = LATE_GU2 + (which == 4 ? LATE_GU3 : 0) + i / 256, up = (i % 256) >= 128;
        t.W = (up ? p.w_up : p.w_gate) + (size_t)e * DM * FE; t.WT = (bf16*)(ws + WS_WGUT + (size_t)e * 512 * DM); t.K = DM; t.N = FE; t.mode = 1 + up; t.r = i % 128; t.f8 = W8_SCALE; return t; }
    int it = which == 1 ? (i < LATE_D2 * 128 ? i : 64 * 128 + (i - LATE_D2 * 128)) : LATE_D2 * 128 + i;
    if (it < 64 * 128) { const int e = it / 128; t.W = p.w_down + (size_t)e * FE * DM; t.WT = (bf16*)(ws + WS_WDT + (size_t)e * DM * FE); t.K = FE; t.N = DM; t.mode = 0; t.r = it % 128; t.f8 = WD8_SCALE; return t; }
    it -= 64 * 128; const int e = it / 256, up = (it % 256) >= 128;
    t.W = (up ? p.w_up : p.w_gate) + (size_t)e * DM * FE; t.WT = (bf16*)(ws + WS_WGUT + (size_t)e * 512 * DM); t.K = DM; t.N = FE; t.mode = 1 + up; t.r = it % 128; t.f8 = W8_SCALE; return t;
}
__device__ __forceinline__ void ti_begin(const P& p, unsigned char* ws, int which, int first, int count, int lane, TItem& tc, float (&cur)[32]) {
    if (first >= count) return;
    tc = which == 0 ? ti_decode0(p, ws, first) : ti_decode_late(p, ws, which, first);
    ti_load(tc, cur, lane);
}
__device__ __forceinline__ void ti_rest(const P& p, unsigned char* ws, LAS float* scr, int which, int first, int count, int stride, int lane, TItem& tc, float (&cur)[32]) {
    if (first >= count) return;
    float nxt[32];
    for (int it = first; it < count; it += stride) {
        const bool more = it + stride < count; TItem tn = tc;
        if (more) { tn = which == 0 ? ti_decode0(p, ws, it + stride) : ti_decode_late(p, ws, which, it + stride); ti_load(tn, nxt, lane); }
        ti_store(tc, cur, scr, lane);
        if (more) {
#pragma unroll
            for (int i = 0; i < 32; ++i) cur[i] = nxt[i];
            tc = tn; }
    }
}
__device__ __forceinline__ void ti_run(const P& p, unsigned char* ws, LAS float* scr, int which, int first, int count, int stride, int lane) {
    TItem tc; float cur[32];
    ti_begin(p, ws, which, first, count, lane, tc, cur);
    ti_rest(p, ws, scr, which, first, count, stride, lane, tc, cur);
}
__device__ __forceinline__ void late_copies(const P& p, unsigned char* ws, LAS unsigned char* lds, int nrem, int c, int G, int wave, int lane, int which, int count) {
    if (nrem > 0 && c < nrem) return;
    __syncthreads();
    const int nw = (nrem > 0 ? G - nrem : G) * NWAVES, w0 = (nrem > 0 ? c - nrem : c) * NWAVES + wave;
    ti_run(p, ws, (LAS float*)(lds + wave * 16384), which, w0, count, nw, lane);
}

struct ModView { const float* part; const float* bias; int b;
    __device__ __forceinline__ float operator[](int idx) const { float s = bias[idx];
#pragma unroll
        for (int kp = 0; kp < 8; ++kp) s += part[(size_t)(kp * 8 + b) * 6144 + idx];
        return s; } };

__device__ __forceinline__ void store_tile_32x64(LAS unsigned char* T, bf16* g0, int rowstride, const u32x2 (&w)[8], int r32, int hi, int lane) {
#pragma unroll
    for (int q = 0; q < 8; ++q) *(LAS u32x2*)(T + r32 * 144 + (32 * (q >> 2) + 8 * (q & 3) + 4 * hi) * 2) = w[q];
    asm volatile("s_waitcnt lgkmcnt(0)" ::: "memory");
#pragma unroll
    for (int j = 0; j < 4; ++j) { const int row = 8 * j + (lane >> 3), pc = lane & 7; const u32x4 v = *(const LAS u32x4*)(T + row * 144 + pc * 16); *(u32x4*)(g0 + (size_t)row * rowstride + pc * 8) = v; }
    asm volatile("s_waitcnt lgkmcnt(0)" ::: "memory");
}

struct MArgs { P p; int ph_lo, ph_hi, dbg, pad; };

__global__ void __launch_bounds__(NTHR, 2) mega(MArgs a) {
    extern __shared__ __attribute__((aligned(16))) unsigned char lds_raw[];
    LAS unsigned char* lds = (LAS unsigned char*)lds_raw;
    const P& p = a.p;
    const int tid = threadIdx.x, lane = tid & 63, wave = __builtin_amdgcn_readfirstlane(tid >> 6);
    const int G = gridDim.x, bx = blockIdx.x, vcu = (G % 8 == 0) ? (bx % 8) * (G / 8) + bx / 8 : bx;
    unsigned char* ws = p.ws;
    float* const outw = a.dbg ? (float*)(ws + WS_RB) : p.out;
    volatile LAS unsigned* bst = (volatile LAS unsigned*)(lds + LDS_MISC + 8192);
    if (tid < 2) bst[tid] = 0u;
    __syncthreads();
    XcdBarrier xbar = xcd_barrier_post((unsigned*)(ws + WS_CTL) + CW_BAR, bst);
#define IN(k) (a.ph_lo <= (k) && (k) < a.ph_hi)
#define SEAM(k) do { if (IN(k) && IN((k) + 1)) xcd_barrier(xbar); } while (0)

    if (IN(0)) for (int rep_ = 0; rep_ < (REP_PH == 0 ? REP_N : 1); ++rep_) { __syncthreads();
        const int gw = vcu * NWAVES + wave, NGW = G * NWAVES;
        TItem ti0; float tic[32];
        ti_begin(p, ws, 0, gw, TI_N0, lane, ti0, tic);
        const int gi = bx * NTHR + tid; const bool pre_ok = (G * NTHR == 2 * NE * DM) && (4 * 128 * 128 == NE * DM);
        float pre_v = 0.f;
        if (pre_ok) pre_v = gi < NE * DM ? p.w_router[(size_t)(gi % DM) * NE + gi / DM] : p.w_sp[gi - NE * DM];
        if (rep_ == 0) {
            LAS float* sc = (LAS float*)(lds);
            LAS float* part = (LAS float*)(lds + 32768);
            for (int u = bx; u < 256; u += G) {
                const int cblk = u & 31, kp = u >> 5;
                __syncthreads();
                for (int i = tid; i < NB * 128; i += NTHR) { const float cv = p.c[(i >> 7) * DM + kp * 128 + (i & 127)]; sc[i] = cv * fast_sigmoid(cv); }
                const int q = tid % 48, rg = tid / 48;
                f32x4 w[16];
                if (tid < 384) {
#pragma unroll
                    for (int r = 0; r < 16; ++r) w[r] = __builtin_nontemporal_load((const f32x4*)(p.w_ada + (size_t)(kp * 128 + rg * 16 + r) * 6144 + cblk * 192 + 4 * q));
                }
                __syncthreads();
                if (tid < 384) {
                    f32x4 acc[8];
#pragma unroll
                    for (int b2 = 0; b2 < 8; ++b2) acc[b2] = (f32x4){0.f, 0.f, 0.f, 0.f};
#pragma unroll
                    for (int r = 0; r < 16; ++r)
#pragma unroll
                        for (int b2 = 0; b2 < 8; ++b2) acc[b2] = acc[b2] + w[r] * sc[b2 * 128 + rg * 16 + r];
#pragma unroll
                    for (int b2 = 0; b2 < 8; ++b2) *(LAS f32x4*)(part + (rg * 8 + b2) * 192 + 4 * q) = acc[b2];
                }
                __syncthreads();
                for (int o = tid; o < NB * 192; o += NTHR) { const int b2 = o / 192, cc = o % 192; float sum = 0.f;
#pragma unroll
                    for (int g2 = 0; g2 < 8; ++g2) sum += part[(g2 * 8 + b2) * 192 + cc];
                    __hip_atomic_store((float*)(ws + WS_MOD) + (size_t)(kp * 8 + b2) * 6144 + cblk * 192 + cc, sum, __ATOMIC_RELAXED, __HIP_MEMORY_SCOPE_AGENT); }
            }
            asm volatile("s_waitcnt vmcnt(0)" ::: "memory");
            __syncthreads();
            if (tid == 0) __hip_atomic_fetch_add((unsigned*)(ws + WS_CTL) + CW_MODCNT, 1u, __ATOMIC_RELAXED, __HIP_MEMORY_SCOPE_AGENT);
        }
        __syncthreads();
        if (pre_ok) {
            if (gi < NE * DM) { const bf16 hi = f2bf(pre_v); bf16* wrt = (bf16*)(ws + WS_WRT); wrt[gi] = hi; wrt[NE * DM + gi] = f2bf(pre_v - bf2f(hi)); }
            else ((bf16*)(ws + WS_WSP))[gi - NE * DM] = f2bf(pre_v);
        } else {
        for (int i = bx * NTHR + tid; i < NE * DM; i += G * NTHR) { const int e = i / DM, k = i % DM; const float w = p.w_router[(size_t)k * NE + e]; const bf16 hi = f2bf(w);
            bf16* wrt = (bf16*)(ws + WS_WRT); wrt[i] = hi; wrt[NE * DM + i] = f2bf(w - bf2f(hi)); }
        for (int i = bx * NTHR + tid; i < 4 * 128 * 128; i += G * NTHR) ((bf16*)(ws + WS_WSP))[i] = f2bf(p.w_sp[i]);
        }
        LAS float* scr = (LAS float*)(lds + wave * 16384);
        ti_rest(p, ws, scr, 0, gw, TI_N0, NGW, lane, ti0, tic);
    }
    if (IN(0) && IN(1)) {
        if (tid == 0) { unsigned sp = 0; while (__hip_atomic_load((unsigned*)(ws + WS_CTL) + CW_MODCNT, __ATOMIC_RELAXED, __HIP_MEMORY_SCOPE_AGENT) < (unsigned)G) { __builtin_amdgcn_s_sleep(1); if (++sp > (1u << 22)) break; }
            __builtin_amdgcn_fence(__ATOMIC_ACQUIRE, "agent"); asm volatile("s_waitcnt vmcnt(0)" ::: "memory"); }
        __syncthreads();
    }
    if (IN(1)) for (int rep_ = 0; rep_ < (REP_PH == 1 ? REP_N : 1); ++rep_) { __syncthreads();
        bf16* h1 = (bf16*)(ws + WS_RA);
        LAS float* prm = (LAS float*)lds;
        for (int base = vcu * 64; base < NT; base += G * 64) {
            const int b = base / SEQ; const ModView mod{(const float*)(ws + WS_MOD), p.b_ada, b};
            __syncthreads();
            for (int k = tid; k < DM; k += NTHR) { prm[k] = p.g_pre_mix[k] * (1.f + mod[1024 + k]); prm[DM + k] = mod[k]; }
            __syncthreads();
            f32x4 xraw[2][2][4];
#define P1_LOAD(buf, r_) do { const f32x4* xr = (const f32x4*)(p.x + (size_t)(base + wave * 8 + (r_)) * DM) + lane; \
                _Pragma("unroll") for (int j = 0; j < 4; ++j) xraw[(buf) >> 1][(buf) & 1][j] = xr[64 * j]; } while (0)
            P1_LOAD(0, 0); P1_LOAD(1, 1); P1_LOAD(2, 2);
#pragma unroll
            for (int it = 0; it < 8; ++it) { const int rr = it, cb = (it & 3) >> 1;
                if (it + 3 < 8) P1_LOAD((it + 3) & 3, it + 3);
#pragma unroll
                for (int q = (it & 1); q < (it & 1) + 1; ++q) { const int t = base + wave * 8 + rr; float s1 = 0.f;
#pragma unroll
                    for (int j = 0; j < 4; ++j) { const f32x4 v = xraw[cb][q][j]; s1 += (v.x * v.x + v.y * v.y) + (v.z * v.z + v.w * v.w); }
                    const float rstd = rsqrtf(wave_sum(s1) * (1.f / DM) + EPS);
                    u32x2* o8 = (u32x2*)(h1 + (size_t)t * DM) + lane;
#pragma unroll
                    for (int j = 0; j < 4; ++j) { const int k = 4 * lane + 256 * j;
                        const f32x4 g = *(const LAS f32x4*)(prm + k), h = *(const LAS f32x4*)(prm + DM + k);
                        const f32x4 r = xraw[cb][q][j] * rstd * g + h;
                        u32x2 w; w.x = cvt_pk_bf16(r.x, r.y); w.y = cvt_pk_bf16(r.z, r.w); o8[64 * j] = w; } } }
#undef P1_LOAD
        }
    }
    SEAM(1);
    if (IN(2)) for (int rep_ = 0; rep_ < (REP_PH == 2 ? REP_N : 1); ++rep_) { __syncthreads();
        DenseOrder S; S.init(ws + WS_RA, ws + WS_WINT, NT, 2560, DM, G, bx, 8);
        EpiInProj E{(bf16*)(ws + WS_RB), (bf16*)(ws + WS_KF), (bf16*)(ws + WS_VT)};
        pg8::gemm_phase<EpiInProj, DenseOrder>(lds, DM, S, E);
        late_copies(p, ws, lds, 640 % G, bx, G, wave, lane, 1, LATE_D2 * 128 + LATE_GU2 * 256);
    }


    SEAM(2);
    if (IN(3)) for (int rep_ = 0; rep_ < (REP_PH == 3 ? REP_N : 1); ++rep_) { __syncthreads();
        const bf16* proj = (const bf16*)(ws + WS_RB); const bf16* vt = (const bf16*)(ws + WS_VT); const bf16* kfm = (const bf16*)(ws + WS_KF); bf16* mixed = (bf16*)(ws + WS_RA);
        LAS float* ssqs = (LAS float*)lds;
        const int r32 = lane & 31, hi = lane >> 5, h = wave;
        TItem ti4; float ti4c[32];
        ti_begin(p, ws, 4, vcu * NWAVES + wave, LATE_GU4 * 256, lane, ti4, ti4c);
        for (int unit = vcu; unit < 256; unit += G) {
            const int b = unit >> 5, pi = unit & 31;
#pragma unroll 1
            for (int uu = 0; uu < 2; ++uu) {
                const int qb = uu == 0 ? pi : 63 - pi, q0 = qb * 32;
                const bf16* qp = proj + (size_t)(b * SEQ + q0 + r32) * 2048 + 1024 + h * HD + hi * 8;
                bf16x8 qr[4];
#pragma unroll
                for (int d0 = 0; d0 < 4; ++d0) qr[d0] = *(const bf16x8*)(qp + d0 * 16);
                f32x16 o0, o1;
#pragma unroll
                for (int r = 0; r < 16; ++r) { o0[r] = 0.f; o1[r] = 0.f; }
                float carry = 1.f;
                const bf16* kbase = kfm + (size_t)(b * NH + h) * 64 * 2048 + lane * 8;
                const bf16* vbase = vt + (size_t)(b * NH + h) * 64 * 2048 + lane * 8;
                bf16x8 kA[4], kB[4], kC[4], vA[2][2], vB[2][2], vC[2][2];
#define ATT_LOAD(KF, VF, kv0_) do { const size_t o_ = (size_t)((kv0_) >> 5) * 2048; _Pragma("unroll") for (int d0 = 0; d0 < 4; ++d0) KF[d0] = *(const bf16x8*)(kbase + o_ + d0 * 512); \
                    _Pragma("unroll") for (int db = 0; db < 2; ++db) _Pragma("unroll") for (int ss = 0; ss < 2; ++ss) VF[db][ss] = *(const bf16x8*)(vbase + o_ + (db * 2 + ss) * 512); } while (0)
#define ATT_STEP(KF, VF, KP, VP, kb_) do { const int kv0 = (kb_) * 32; \
                    ATT_LOAD(KP, VP, ((kb_) >= 2 ? kv0 - 64 : 0)); \
                    f32x16 pz; _Pragma("unroll") for (int r = 0; r < 16; ++r) pz[r] = 0.f; \
                    _Pragma("unroll") for (int d0 = 0; d0 < 4; ++d0) pz = MFMA32(KF[d0], qr[d0], pz); \
                    if ((kb_) == qb) sb_tile(pz, carry, true, kv0 + 4 * hi - (q0 + r32), hi); else sb_tile(pz, carry, false, 0, hi); \
                    _Pragma("unroll") for (int sstep = 0; sstep < 2; ++sstep) { \
                        u32x4 pk; pk.x = cvtpk(pz[8 * sstep + 0], pz[8 * sstep + 1]); pk.y = cvtpk(pz[8 * sstep + 2], pz[8 * sstep + 3]); pk.z = cvtpk(pz[8 * sstep + 4], pz[8 * sstep + 5]); pk.w = cvtpk(pz[8 * sstep + 6], pz[8 * sstep + 7]); \
                        const bf16x8 xs = __builtin_bit_cast(bf16x8, pk); \
                        o0 = MFMA32(VF[0][sstep], xs, o0); o1 = MFMA32(VF[1][sstep], xs, o1); } \
                      \
                    done = (kb_) == 0 || __all(carry == 0.f); } while (0)
                ATT_LOAD(kA, vA, q0); ATT_LOAD(kB, vB, (qb >= 1 ? q0 - 32 : 0));
                bool done = false;
#pragma unroll 1
                for (int kb = qb; ; kb -= 3) {
                    ATT_STEP(kA, vA, kC, vC, kb); if (done) break;
                    ATT_STEP(kB, vB, kA, vA, kb - 1); if (done) break;
                    ATT_STEP(kC, vC, kB, vB, kb - 2); if (done) break;
                }
#undef ATT_STEP
#undef ATT_LOAD
                float sq = 0.f;
#pragma unroll
                for (int r = 0; r < 16; ++r) sq += o0[r] * o0[r] + o1[r] * o1[r];
                sq += __shfl_xor(sq, 32);
                const float* gb = p.g_branch + 512 + h * HD + 4 * hi;
                f32x4 gav[4], gcv[4];
#pragma unroll
                for (int g4 = 0; g4 < 4; ++g4) { gav[g4] = *(const f32x4*)(gb + 8 * g4); gcv[g4] = *(const f32x4*)(gb + 32 + 8 * g4); }
                __syncthreads();
                if (hi == 0) ssqs[h * 32 + r32] = sq;
                __syncthreads();
                float tot = 0.f;
#pragma unroll
                for (int w2 = 0; w2 < 8; ++w2) tot += ssqs[w2 * 32 + r32];
                const float rstd = rsqrtf(tot * (1.f / DSB) + EPS);
                u32x2 wq[8];
#pragma unroll
                for (int g4 = 0; g4 < 4; ++g4) {
                    const f32x4 ga = gav[g4], gc = gcv[g4];
                    wq[g4].x = cvtpk(o0[4 * g4] * rstd * ga.x, o0[4 * g4 + 1] * rstd * ga.y); wq[g4].y = cvtpk(o0[4 * g4 + 2] * rstd * ga.z, o0[4 * g4 + 3] * rstd * ga.w);
                    wq[4 + g4].x = cvtpk(o1[4 * g4] * rstd * gc.x, o1[4 * g4 + 1] * rstd * gc.y); wq[4 + g4].y = cvtpk(o1[4 * g4 + 2] * rstd * gc.z, o1[4 * g4 + 3] * rstd * gc.w); }
                store_tile_32x64(lds + 2048 + wave * 4608, mixed + (size_t)(b * SEQ + q0) * DM + 512 + h * HD, DM, wq, r32, hi, lane);
            }
        }
        __syncthreads();
        ti_rest(p, ws, (LAS float*)(lds + wave * 16384), 4, vcu * NWAVES + wave, LATE_GU4 * 256, G * NWAVES, lane, ti4, ti4c);
    }
    __syncthreads();
    if (IN(4)) for (int rep_ = 0; rep_ < (REP_PH == 4 ? REP_N : 1); ++rep_) { __syncthreads();
        constexpr int RS = 1040;
        const bf16* proj = (const bf16*)(ws + WS_RB); const bf16* wsp = (const bf16*)(ws + WS_WSP); bf16* mixed = (bf16*)(ws + WS_RA);
        LAS unsigned char* VN = lds; LAS float* ssq = (LAS float*)(lds + 128 * RS);
        const int r32 = lane & 31, hi = lane >> 5;
        for (int unit = vcu; unit < 256; unit += G) {
            const int ih = unit & 1, t0 = (unit >> 1) * 128, nj = 64 * (ih + 1);
            __syncthreads();
            const f32x4 lg0 = *(const f32x4*)(p.ln_g + 8 * lane), lg1 = *(const f32x4*)(p.ln_g + 8 * lane + 4), lb0 = *(const f32x4*)(p.ln_b + 8 * lane), lb1 = *(const f32x4*)(p.ln_b + 8 * lane + 4);
            const int g = wave >> 1, ch0 = g * 128 + (wave & 1) * 64;
            const bf16* wbase = wsp + (size_t)(g * 128 + 64 * ih + r32) * 128 + 8 * hi;
            bf16x8 bw0[4][2], bw1[4][2];
            u32x2 upre[2][8]; float bspre[2];
#pragma unroll
            for (int it = 0; it < 2; ++it) { const int i = 64 * ih + 32 * it + r32; bspre[it] = p.b_sp[g * 128 + i];
                const bf16* up = proj + (size_t)(t0 + i) * 2048 + ch0 + 4 * hi;
#pragma unroll
                for (int ct = 0; ct < 2; ++ct)
#pragma unroll
                    for (int g4 = 0; g4 < 4; ++g4) upre[it][4 * ct + g4] = *(const u32x2*)(up + ct * 32 + 8 * g4); }
#pragma unroll
            for (int q = 0; q < 4; ++q)
#pragma unroll
                for (int it = 0; it < 2; ++it) { bw0[q][it] = *(const bf16x8*)(wbase + (size_t)(32 * it) * 128 + 16 * q); bw1[q][it] = *(const bf16x8*)(wbase + (size_t)(32 * it) * 128 + 16 * (ih * 4 + q)); }
#pragma unroll 1
            for (int j0 = wave; j0 < nj; j0 += 32) {
                u32x4 raw4[4];
#pragma unroll
                for (int q = 0; q < 4; ++q) raw4[q] = *(const u32x4*)(proj + (size_t)(t0 + min(j0 + 8 * q, nj - 1)) * 2048 + 512 + 8 * lane);
#pragma unroll
                for (int q = 0; q < 4; ++q) { const int j = j0 + 8 * q; const u32x4 raw = raw4[q];
                    float v[8] = {bflo(raw.x), bfhi(raw.x), bflo(raw.y), bfhi(raw.y), bflo(raw.z), bfhi(raw.z), bflo(raw.w), bfhi(raw.w)};
                    float sm = 0.f;
#pragma unroll
                    for (int i = 0; i < 8; ++i) sm += v[i];
                    const float mu = wave_sum(sm) * (1.f / DG); float q2 = 0.f;
#pragma unroll
                    for (int i = 0; i < 8; ++i) { v[i] -= mu; q2 += v[i] * v[i]; }
                    const float rstd = rsqrtf(wave_sum(q2) * (1.f / DG) + EPS);
                    u32x4 o; o.x = cvtpk(v[0] * rstd * lg0.x + lb0.x, v[1] * rstd * lg0.y + lb0.y); o.y = cvtpk(v[2] * rstd * lg0.z + lb0.z, v[3] * rstd * lg0.w + lb0.w);
                    o.z = cvtpk(v[4] * rstd * lg1.x + lb1.x, v[5] * rstd * lg1.y + lb1.y); o.w = cvtpk(v[6] * rstd * lg1.z + lb1.z, v[7] * rstd * lg1.w + lb1.w);
                    if (j < nj) *(LAS u32x4*)(VN + j * RS + lane * 16) = o; }
            }
            __syncthreads();
            f32x16 acc[2][2];
#pragma unroll
            for (int ct = 0; ct < 2; ++ct)
#pragma unroll
                for (int it = 0; it < 2; ++it)
#pragma unroll
                    for (int r = 0; r < 16; ++r) acc[ct][it][r] = 0.f;
            const int trb = (8 * hi + ((lane & 15) >> 2)) * RS + (ch0 + 16 * ((lane >> 4) & 1) + 4 * (lane & 3)) * 2;
#define GM_BATCH(BW, s4_) do { _Pragma("unroll") for (int q = 0; q < 4; ++q) { const int sstep = (s4_) + q; bf16x8 af[2]; \
                    _Pragma("unroll") for (int ct = 0; ct < 2; ++ct) { \
                        const s16x4_t lo_ = __builtin_amdgcn_ds_read_tr16_b64_v4i16((LAS s16x4_t*)(VN + trb + (16 * sstep) * RS + ct * 64)); \
                        const s16x4_t hi_ = __builtin_amdgcn_ds_read_tr16_b64_v4i16((LAS s16x4_t*)(VN + trb + (16 * sstep + 4) * RS + ct * 64)); \
                        af[ct] = __builtin_bit_cast(bf16x8, __builtin_shufflevector(lo_, hi_, 0, 1, 2, 3, 4, 5, 6, 7)); } \
                    _Pragma("unroll") for (int ct = 0; ct < 2; ++ct) _Pragma("unroll") for (int it = 0; it < 2; ++it) acc[ct][it] = MFMA32(af[ct], BW[q][it], acc[ct][it]); } } while (0)
            GM_BATCH(bw0, 0);
            if (ih) GM_BATCH(bw1, 4);
#undef GM_BATCH
            float sq[2];
#pragma unroll
            for (int it = 0; it < 2; ++it) { const float bs = bspre[it]; sq[it] = 0.f;
#pragma unroll
                for (int ct = 0; ct < 2; ++ct)
#pragma unroll
                    for (int g4 = 0; g4 < 4; ++g4) { const u32x2 uu2 = upre[it][4 * ct + g4];
                        const float u0 = bflo(uu2.x), u1 = bfhi(uu2.x), u2 = bflo(uu2.y), u3 = bfhi(uu2.y);
                        float a0 = u0 * (acc[ct][it][4 * g4] + bs), a1 = u1 * (acc[ct][it][4 * g4 + 1] + bs), a2 = u2 * (acc[ct][it][4 * g4 + 2] + bs), a3 = u3 * (acc[ct][it][4 * g4 + 3] + bs);
                        acc[ct][it][4 * g4] = a0; acc[ct][it][4 * g4 + 1] = a1; acc[ct][it][4 * g4 + 2] = a2; acc[ct][it][4 * g4 + 3] = a3;
                        sq[it] += (a0 * a0 + a1 * a1) + (a2 * a2 + a3 * a3); }
                sq[it] += __shfl_xor(sq[it], 32);
                if (hi == 0) ssq[wave * 64 + it * 32 + r32] = sq[it]; }
            f32x4 gbv[8];
#pragma unroll
            for (int ct = 0; ct < 2; ++ct)
#pragma unroll
                for (int g4 = 0; g4 < 4; ++g4) gbv[4 * ct + g4] = *(const f32x4*)(p.g_branch + ch0 + 4 * hi + ct * 32 + 8 * g4);
            __syncthreads();
#pragma unroll
            for (int it = 0; it < 2; ++it) { const int i = 64 * ih + 32 * it + r32; float tot = 0.f;
#pragma unroll
                for (int w2 = 0; w2 < 8; ++w2) tot += ssq[w2 * 64 + it * 32 + r32];
                const float rstd = rsqrtf(tot * (1.f / DG) + EPS);
                u32x2 wq[8];
#pragma unroll
                for (int ct = 0; ct < 2; ++ct)
#pragma unroll
                    for (int g4 = 0; g4 < 4; ++g4) { const f32x4 gb = gbv[4 * ct + g4];
                        wq[4 * ct + g4].x = cvtpk(acc[ct][it][4 * g4] * rstd * gb.x, acc[ct][it][4 * g4 + 1] * rstd * gb.y); wq[4 * ct + g4].y = cvtpk(acc[ct][it][4 * g4 + 2] * rstd * gb.z, acc[ct][it][4 * g4 + 3] * rstd * gb.w); }
                store_tile_32x64(lds + wave * 4608, mixed + (size_t)(t0 + 64 * ih + 32 * it) * DM + ch0, DM, wq, r32, hi, lane); }
        }
        { __syncthreads();
          constexpr int N3 = LATE_GU3 * 256; LAS float* scr = (LAS float*)(lds + wave * 16384);
          if (G % 2 == 0 && N3 == 16 * G) { const int half = vcu >> 1; if ((vcu & 1) == 0) { const int v0 = (half * NWAVES + wave) * 3; ti_run(p, ws, scr, 3, v0, v0 + 3, 1, lane); } else { const int v0 = 12 * G + half * NWAVES + wave; ti_run(p, ws, scr, 3, v0, v0 + 1, 1, lane); } }
          else ti_run(p, ws, scr, 3, vcu * NWAVES + wave, N3, G * NWAVES, lane); }
    }
    SEAM(4);
    if (IN(5)) for (int rep_ = 0; rep_ < (REP_PH == 5 ? REP_N : 1); ++rep_) { __syncthreads();
        DenseOrder S; S.init(ws + WS_RA, ws + WS_WOUTT, NT, DM, DM, G, bx);
        EpiY E{(bf16*)(ws + WS_RB)};
        pg8::gemm_phase<EpiY, DenseOrder>(lds, DM, S, E);
    }
    int p6_prm_b = -1;
    if (IN(5) && IN(6) && vcu * 64 < NT) { const int b = (vcu * 64) / SEQ; const ModView mod{(const float*)(ws + WS_MOD), p.b_ada, b};
        LAS float* prm = (LAS float*)(lds + LDS_EXTRA);
        for (int k = tid; k < DM; k += NTHR) { prm[k] = p.g_post_mix[k] * mod[2048 + k]; prm[DM + k] = p.g_pre_ffn[k] * (1.f + mod[4096 + k]); prm[2 * DM + k] = mod[3072 + k]; }
        p6_prm_b = b; }
    SEAM(5);
    if (IN(6)) for (int rep_ = 0; rep_ < (REP_PH == 6 ? REP_N : 1); ++rep_) { __syncthreads();
        LAS float* part = (LAS float*)lds;
        LAS int* lcnt = (LAS int*)(lds + 131072);
        LAS int* lbase = lcnt + 64;
        LAS int* lent = lbase + 64;
        int* gcount = (int*)(ws + WS_CTL) + CTL_GCOUNT;
        int* list = (int*)(ws + WS_LIST);
        const bf16* wrt = (const bf16*)(ws + WS_WRT);
        bf16* h2g = (bf16*)(ws + WS_RA);
        const int fr = lane & 15, fq = lane >> 4;
        for (int base = vcu * 64; base < NT; base += G * 64) {
            __syncthreads();
            if (tid < 64) lcnt[tid] = 0;
            { const int b = base / SEQ; const ModView mod{(const float*)(ws + WS_MOD), p.b_ada, b};
              LAS float* prm = (LAS float*)(lds + LDS_EXTRA);
              if (b != p6_prm_b) { for (int k = tid; k < DM; k += NTHR) { prm[k] = p.g_post_mix[k] * mod[2048 + k]; prm[DM + k] = p.g_pre_ffn[k] * (1.f + mod[4096 + k]); prm[2 * DM + k] = mod[3072 + k]; } p6_prm_b = b; }
              __syncthreads(); }
            const float l2warm = *(const float*)(wrt + (size_t)(((vcu & 7) < 4 ? (vcu & 7) * 16 : 64 + ((vcu & 7) - 4) * 16) + fr) * DM + 128 * wave + 32 * ((vcu >> 3) & 3) + 8 * fq);
            { const LAS float* prm = (const LAS float*)(lds + LDS_EXTRA);
              u32x2 yraw[3][1][4]; f32x4 xraw[3][1][4];
#define P6_LOAD(buf, r_) do { const int t = base + wave * 8 + (r_); \
                    const u32x2* yr = (const u32x2*)((const bf16*)(ws + WS_RB) + (size_t)t * DM) + lane; const f32x4* xr = (const f32x4*)(p.x + (size_t)t * DM) + lane; \
                    _Pragma("unroll") for (int j = 0; j < 4; ++j) { yraw[buf][0][j] = yr[64 * j]; xraw[buf][0][j] = __builtin_nontemporal_load(xr + 64 * j); } } while (0)
              P6_LOAD(0, 0); P6_LOAD(1, 1);
#pragma unroll
              for (int it = 0; it < 8; ++it) {
                const int rr = it, cb = it % 3;
                if (it + 2 < 8) P6_LOAD((it + 2) % 3, it + 2);
#pragma unroll
                for (int q = 0; q < 1; ++q) { const int t = base + wave * 8 + rr + q;
                    f32x4 yv[4], xv[4]; float s1 = 0.f;
#pragma unroll
                    for (int j = 0; j < 4; ++j) { const u32x2 yb = yraw[cb][q][j]; yv[j] = (f32x4){bflo(yb.x), bfhi(yb.x), bflo(yb.y), bfhi(yb.y)}; xv[j] = xraw[cb][q][j];
                        s1 += (yv[j].x * yv[j].x + yv[j].y * yv[j].y) + (yv[j].z * yv[j].z + yv[j].w * yv[j].w); }
                    const float ry = rsqrtf(wave_sum(s1) * (1.f / DM) + EPS); float s2 = 0.f;
#pragma unroll
                    for (int j = 0; j < 4; ++j) { const int k = 4 * lane + 256 * j;
                        const f32x4 gpa = *(const LAS f32x4*)(prm + k);
                        xv[j] = xv[j] + gpa * (yv[j] * ry);
                        { u32x2 xb; xb.x = cvtpk(xv[j].x, xv[j].y); xb.y = cvtpk(xv[j].z, xv[j].w); *((u32x2*)(outw + (size_t)t * DM) + lane + 64 * j) = xb; }
                        s2 += (xv[j].x * xv[j].x + xv[j].y * xv[j].y) + (xv[j].z * xv[j].z + xv[j].w * xv[j].w); }
                    const float rx = rsqrtf(wave_sum(s2) * (1.f / DM) + EPS);
#pragma unroll
                    for (int j = 0; j < 4; ++j) { const int k = 4 * lane + 256 * j;
                        const f32x4 gfs = *(const LAS f32x4*)(prm + DM + k), h0 = *(const LAS f32x4*)(prm + 2 * DM + k);
                        const f32x4 h = xv[j] * rx * gfs + h0;
                        u32x2 hi; hi.x = cvtpk(h.x, h.y); hi.y = cvtpk(h.z, h.w);
                        const f32x4 d = h - (f32x4){bflo(hi.x), bfhi(hi.x), bflo(hi.y), bfhi(hi.y)}; u32x2 lo; lo.x = cvtpk(d.x, d.y); lo.y = cvtpk(d.z, d.w);
                        *((u32x2*)(h2g + (size_t)t * DM) + lane + 64 * j) = hi;
                        { int pk = __builtin_amdgcn_cvt_pk_fp8_f32(__builtin_amdgcn_fmed3f(h.x, -448.f, 448.f), __builtin_amdgcn_fmed3f(h.y, -448.f, 448.f), 0, false);
                          pk = __builtin_amdgcn_cvt_pk_fp8_f32(__builtin_amdgcn_fmed3f(h.z, -448.f, 448.f), __builtin_amdgcn_fmed3f(h.w, -448.f, 448.f), pk, true);
                          *((int*)(ws + WS_H2F8 + (size_t)t * DM) + lane + 64 * j) = pk; }
                        { const int row = wave * 8 + rr + q, ch = (lane >> 1) + 32 * j;
                          *(LAS u32x2*)(lds + row * 2048 + ((ch ^ (row & 7)) << 4) + 8 * (lane & 1)) = lo; } } }
              }
#undef P6_LOAD
            }
            asm volatile("s_waitcnt vmcnt(0)" ::: "memory");
            __syncthreads();
            asm volatile("" :: "v"(l2warm));
            const float rbias = p.router_bias[lane];
            { f32x4 ac[4][4];
#pragma unroll
              for (int mt = 0; mt < 4; ++mt)
#pragma unroll
                  for (int nt = 0; nt < 4; ++nt) ac[mt][nt] = (f32x4){0.f, 0.f, 0.f, 0.f};
              const size_t ao = (size_t)(base + fr) * DM + 128 * wave + 8 * fq; const bf16* bp = wrt + (size_t)fr * DM + 128 * wave + 8 * fq;
              bf16x8 ah[2][4], al[4], bh[2][4], bl[2][4];
#define P6B_LOAD(buf, ks) do { _Pragma("unroll") for (int mt = 0; mt < 4; ++mt) { ah[buf][mt] = *(const bf16x8*)(h2g + ao + (size_t)mt * 16 * DM + 32 * (ks)); } \
                  _Pragma("unroll") for (int nt = 0; nt < 4; ++nt) { bh[buf][nt] = *(const bf16x8*)(bp + (size_t)nt * 16 * DM + 32 * (ks)); bl[buf][nt] = *(const bf16x8*)(bp + (size_t)(64 + nt * 16) * DM + 32 * (ks)); } } while (0)
              P6B_LOAD(0, 0);
#pragma unroll
              for (int ks = 0; ks < 4; ++ks) { const int cb = ks & 1;
                  if (ks < 3) P6B_LOAD(cb ^ 1, ks + 1);
#pragma unroll
                  for (int mt = 0; mt < 4; ++mt) { const int row = mt * 16 + fr, ch = 16 * wave + 4 * ks + fq; al[mt] = *(const LAS bf16x8*)(lds + row * 2048 + ((ch ^ (row & 7)) << 4)); }
#pragma unroll
                  for (int mt = 0; mt < 4; ++mt)
#pragma unroll
                      for (int nt = 0; nt < 4; ++nt) { ac[mt][nt] = __builtin_amdgcn_mfma_f32_16x16x32_bf16(ah[cb][mt], bh[cb][nt], ac[mt][nt], 0, 0, 0);
                          ac[mt][nt] = __builtin_amdgcn_mfma_f32_16x16x32_bf16(al[mt], bh[cb][nt], ac[mt][nt], 0, 0, 0); ac[mt][nt] = __builtin_amdgcn_mfma_f32_16x16x32_bf16(ah[cb][mt], bl[cb][nt], ac[mt][nt], 0, 0, 0); } }
#undef P6B_LOAD
              __syncthreads();
#pragma unroll
              for (int mt = 0; mt < 4; ++mt)
#pragma unroll
                  for (int nt = 0; nt < 4; ++nt)
#pragma unroll
                      for (int r = 0; r < 4; ++r) part[(wave * 64 + mt * 16 + 4 * fq + r) * 64 + nt * 16 + fr] = ac[mt][nt][r];
            }
            __syncthreads();
#pragma unroll 4
            for (int rr = 0; rr < 8; ++rr) {
                const int tl = wave * 8 + rr, t = base + tl;
                float lgt = 0.f;
#pragma unroll
                for (int w2 = 0; w2 < 8; ++w2) lgt += part[(w2 * 64 + tl) * 64 + lane];
                const float sg = __builtin_amdgcn_rcpf(1.f + __expf(-lgt)); const float bi = sg + rbias;
                const float m1 = group8_max(bi);
                const unsigned gb = (unsigned)(__ballot(bi == m1) >> (lane & ~7)) & 0xffu;
                const int first = __builtin_ctz(gb);
                const float m2 = group8_max((lane & 7) == first ? -INFINITY : bi);
                const float gs = m1 + m2; const int g = lane >> 3; int grank = 0;
#pragma unroll
                for (int g2 = 0; g2 < 8; ++g2) { const float v = rdlane(gs, g2 * 8); grank += (v > gs || (v == gs && g2 < g)) ? 1 : 0; }
                const bool gsel = grank < TKG; const float mk = gsel ? bi : -INFINITY;
                const unsigned ub = __float_as_uint(bi);
                const unsigned key = gsel ? ((ub & 0x80000000u) ? ~ub : (ub | 0x80000000u)) : 0u;
                unsigned T = 0u;
#pragma unroll
                for (int bb = 31; bb >= 0; --bb) { const unsigned trial = T | (1u << bb); if (__builtin_popcountll(__ballot(key >= trial)) >= TOPK) T = trial; }
                const unsigned long long gtm = __ballot(key > T), eqm = __ballot(key == T), ltl = (1ull << lane) - 1ull;
                const int need = TOPK - __builtin_popcountll(gtm);
                const bool sel = key > T || (key == T && __builtin_popcountll(eqm & ltl) < need);
                const int slot = __builtin_popcountll(__ballot(sel) & ltl);
                const float wsum = wave_sum(sel ? sg : 0.f);
                if (sel) { const float w = sg / wsum * ROUTED_SCALE; const int tk = t * 8 + slot, l = lane;
                    const int pos = __hip_atomic_fetch_add(lcnt + l, 1, __ATOMIC_RELAXED, __HIP_MEMORY_SCOPE_WORKGROUP);
                    const int ei = tl * 8 + slot; lent[ei * 2 + 0] = (int)((unsigned)l | ((unsigned)pos << 6) | ((unsigned)tk << 15)); lent[ei * 2 + 1] = __builtin_bit_cast(int, w); }
            }
            __syncthreads();
            if (tid < 64) lbase[tid] = (lcnt[tid] && !a.dbg) ? atomicAdd(gcount + tid, lcnt[tid]) : 0;
            __syncthreads();
            { const unsigned pk = (unsigned)lent[tid * 2 + 0]; const int l = pk & 63u, pos = (pk >> 6) & 511u; if (!a.dbg) *(u32x2*)(list + ((size_t)l * NT + lbase[l] + pos) * 2) = (u32x2){pk >> 15, (unsigned)lent[tid * 2 + 1]}; }
        }
    }
    SEAM(6);
    GTable t8; bool t8_built = false;
    if (IN(7)) for (int rep_ = 0; rep_ < (REP_PH == 7 ? REP_N : 1); ++rep_) { __syncthreads();
        const int* gcount = (const int*)(ws + WS_CTL) + CTL_GCOUNT;
        GateUpOrder S; S.T = build_table(lds + LDS_MISC, gcount, 2, vcu, G); S.H2 = (const char*)(ws + WS_H2F8); S.W = (const char*)(ws + WS_WGUT); S.list = (const int*)(ws + WS_LIST); S.G = G; S.c = vcu;
        EpiGateUp E{(unsigned char*)(ws + WS_RB)};
        pg8::gemm_phase<EpiGateUp, GateUpOrder, true>(lds, DM / 2, S, E, 0x7a7f);
        late_copies(p, ws, lds, S.T.pre[S.T.nent] % G, vcu, G, wave, lane, 2, (64 - LATE_D2) * 128);
        if (IN(8)) { t8 = build_table(lds + LDS_MISC, gcount, 4, vcu, G); t8_built = true; }
    }
    SEAM(7);
    if (IN(8)) for (int rep_ = 0; rep_ < (REP_PH == 8 ? REP_N : 1); ++rep_) { __syncthreads();
        const int* gcount = (const int*)(ws + WS_CTL) + CTL_GCOUNT;
        DownOrder S; S.T = t8_built ? t8 : build_table(lds + LDS_MISC, gcount, 4, vcu, G); S.ACT = (const char*)(ws + WS_RB); S.W = (const char*)(ws + WS_WDT); S.list = (const int*)(ws + WS_LIST); S.G = G; S.c = vcu;
        EpiDown E{(unsigned char*)(ws + WS_YP), (unsigned char*)(ws + WS_RA)};
        pg8::gemm_phase<EpiDown, DownOrder, true>(lds, FE / 2, S, E, 0x7f7b);
    }
    int p10_prm_b = -1;
    if (IN(8) && IN(10) && vcu * 64 < NT) { const int b = (vcu * 64) / SEQ; const ModView mod{(const float*)(ws + WS_MOD), p.b_ada, b}; LAS float* prm = (LAS float*)lds;
        for (int k = tid; k < DM; k += NTHR) prm[k] = mod[5120 + k] * p.g_post_ffn[k];
        p10_prm_b = b; }
    SEAM(8);
    if (IN(10)) for (int rep_ = 0; rep_ < (REP_PH == 10 ? REP_N : 1); ++rep_) { __syncthreads();
        const unsigned char* yp = (const unsigned char*)(ws + WS_YP); const unsigned char* ys = (const unsigned char*)(ws + WS_RA);
        LAS float* prm = (LAS float*)lds;
        for (int base = vcu * 64; base < NT; base += G * 64) {
            const int b = base / SEQ; const ModView mod{(const float*)(ws + WS_MOD), p.b_ada, b};
            __syncthreads();
            if (b != p10_prm_b) { for (int k = tid; k < DM; k += NTHR) prm[k] = mod[5120 + k] * p.g_post_ffn[k]; p10_prm_b = b; }
            __syncthreads();
            u32x4 raw[3][9]; u32x2 x1r[3][4];
            LAS float* tsp = (LAS float*)(lds + 8192 + wave * 4096);
#define P10_LOAD(buf, i_) do { const int t = base + wave * 8 + (i_); \
                _Pragma("unroll") for (int r = 0; r < 8; ++r) raw[buf][r] = __builtin_nontemporal_load((const u32x4*)(yp + ((size_t)t * 8 + r) * DM + 16 * lane)); \
                raw[buf][8] = __builtin_nontemporal_load((const u32x4*)(ys + (size_t)t * DM + 16 * lane)); \
                _Pragma("unroll") for (int j = 0; j < 4; ++j) x1r[buf][j] = *(const u32x2*)((const bf16*)(p.out + (size_t)t * DM) + 256 * j + 4 * lane); } while (0)
            P10_LOAD(0, 0); P10_LOAD(1, 1);
#pragma unroll
            for (int i = 0; i < 8; ++i) { const int cb = i % 3, t = base + wave * 8 + i;
                if (i + 2 < 8) P10_LOAD((i + 2) % 3, i + 2);
                float y[16];
#pragma unroll
                for (int e = 0; e < 16; ++e) y[e] = 0.f;
#pragma unroll
                for (int r = 0; r < 9; ++r)
#pragma unroll
                    for (int j = 0; j < 4; ++j) { const f32x2 lo = __builtin_amdgcn_cvt_pk_f32_fp8((int)raw[cb][r][j], false), hi2 = __builtin_amdgcn_cvt_pk_f32_fp8((int)raw[cb][r][j], true);
                        y[4 * j] += lo.x; y[4 * j + 1] += lo.y; y[4 * j + 2] += hi2.x; y[4 * j + 3] += hi2.y; }
                float sq = 0.f;
#pragma unroll
                for (int e = 0; e < 16; ++e) { y[e] *= (1.f / YP_SCALE); sq += y[e] * y[e]; }
                const float r_ = rsqrtf(wave_sum(sq) * (1.f / DM) + EPS);
#pragma unroll
                for (int j = 0; j < 4; ++j) { f32x4 yv; yv.x = y[4 * j]; yv.y = y[4 * j + 1]; yv.z = y[4 * j + 2]; yv.w = y[4 * j + 3]; *(LAS f32x4*)(tsp + 16 * lane + 4 * j) = yv; }
                if (i == 0) asm volatile("s_waitcnt vmcnt(26) lgkmcnt(0)" ::: "memory"); else if (i <= 5) asm volatile("s_waitcnt vmcnt(30) lgkmcnt(0)" ::: "memory");
                else if (i == 6) asm volatile("s_waitcnt vmcnt(17) lgkmcnt(0)" ::: "memory"); else asm volatile("s_waitcnt vmcnt(4) lgkmcnt(0)" ::: "memory");
#pragma unroll
                for (int j = 0; j < 4; ++j) { const int k = 256 * j + 4 * lane;
                    const f32x4 gg = *(const LAS f32x4*)(prm + k), yv = *(const LAS f32x4*)(tsp + k);
                    const u32x2 xr_ = x1r[cb][j];
                    const f32x4 x1 = {bflo(xr_.x), bfhi(xr_.x), bflo(xr_.y), bfhi(xr_.y)};
                    *(f32x4*)(outw + (size_t)t * DM + k) = x1 + gg * (yv * r_); }
                asm volatile("s_waitcnt lgkmcnt(0)" ::: "memory"); }
#undef P10_LOAD
        }
    }
#undef IN
#undef SEAM
}

static int g_grid = 0;
static bool mega_setup() {
    if (g_grid == 0) {
        int dev = 0, cus = 0, per_cu = 0;
        if (hipGetDevice(&dev) != hipSuccess || hipDeviceGetAttribute(&cus, hipDeviceAttributeMultiprocessorCount, dev) != hipSuccess) { g_grid = -1; return false; }
        if (hipFuncSetAttribute((const void*)mega, hipFuncAttributeMaxDynamicSharedMemorySize, LDS_BYTES) != hipSuccess) { fprintf(stderr, "hipFuncSetAttribute failed\n"); g_grid = -1; return false; }
        if (hipOccupancyMaxActiveBlocksPerMultiprocessor(&per_cu, (const void*)mega, NTHR, LDS_BYTES) != hipSuccess || per_cu < 1) { fprintf(stderr, "occupancy query: %d\n", per_cu); (void)hipGetLastError(); per_cu = 1; }
        g_grid = cus;
    }
    return g_grid > 0;
}
static void launch_phases(const P& p, int lo, int hi, hipStream_t stream, int dbg = 0) {
    MArgs a{}; a.p = p; a.ph_lo = lo; a.ph_hi = hi; a.dbg = dbg;
    void* args[] = {&a};
    hipError_t e = hipLaunchCooperativeKernel((const void*)mega, dim3(g_grid), dim3(NTHR), args, LDS_BYTES, stream);
    if (e != hipSuccess) fprintf(stderr, "cooperative launch failed: %s (grid %d)\n", hipGetErrorString(e), g_grid);
}

extern "C" void kernel_launch(void* const* d_in, const int* in_sizes, int n_in, void* d_out, int out_size, void* d_ws, size_t ws_size, hipStream_t stream) {
    if (n_in != 23 || ws_size < WS_END) { fprintf(stderr, "kernel_launch: unexpected n_in %d / ws_size %zu\n", n_in, ws_size); return; }
    if (!mega_setup()) return;
    P p{};
    const float** f = (const float**)&p;
    for (int i = 0; i < 23; ++i) f[i] = (const float*)d_in[i];
    p.out = (float*)d_out; p.ws = (unsigned char*)d_ws;
    (void)hipMemsetAsync((char*)d_ws + WS_CTL, 0, 32768, stream);
    launch_phases(p, 0, 11, stream);
#if defined(XTRA_PH)
    for (int i = 0; i < XTRA_N; ++i) launch_phases(p, XTRA_PH, XTRA_PH + 1, stream, 1);
#endif
}
```
